# Optimizing an MI355X kernel written in HIP

```python
import math
import jax, jax.numpy as jnp
from jax import lax
import numpy as np

D_MODEL = 1024
BATCH = 2
SEQ = 8192
DEPTH = 2

D_MIX = D_MODEL
EPS = 1e-6
MLA_HEADS = 8
MLA_NOPE = 64
MLA_ROPE = 32
MLA_V = 64
MLA_Q_LORA = 256
MLA_KV_LORA = 128
MLA_WIDTH = MLA_HEADS * MLA_V
ROPE_THETA = 10000.0
Q_BLOCK = 128
HY_WIDTH = D_MIX // 4
HY_ORDER = 2
HY_SHORT = 3
HY_BANDS = 8
HY_POS_FEAT = 1 + 2 * HY_BANDS
HY_FILT_HID = 64
HY_DECAY_MIN = 3.07
HY_DECAY_MAX = 15.35
SSM_WIDTH = D_MIX // 4
SSM_HEADDIM = 64
SSM_HEADS = SSM_WIDTH // SSM_HEADDIM
SSM_GROUPS = 2
SSM_STATE = 128
SSM_CONV = 5
SSM_CHUNK = 128
SSM_CONV_DIM = SSM_WIDTH + 2 * SSM_GROUPS * SSM_STATE
N_EXPERTS = 16
EXPERT_FF = 2048
EC_CAPACITY_FACTOR = 2
PLE_DIM = 256
IN_SPLITS = (MLA_Q_LORA, MLA_KV_LORA, MLA_ROPE, (HY_ORDER + 1) * HY_WIDTH, SSM_WIDTH, SSM_CONV_DIM, 2 * SSM_HEADS)
N_IN = MLA_Q_LORA + MLA_KV_LORA + MLA_ROPE + (HY_ORDER + 1) * HY_WIDTH + SSM_WIDTH + SSM_CONV_DIM + 2 * SSM_HEADS

kernel_name = 'hybrid_mla_hyena_ssd_ecmoe_encoder'


def rmsnorm(x, g):
    xf = x.astype(jnp.float32)
    y = xf * lax.rsqrt(jnp.mean(xf * xf, axis=-1, keepdims=True) + EPS)
    return (y * g.astype(jnp.float32)).astype(x.dtype)


def split_cols(a, sizes):
    offs = [int(o) for o in np.cumsum(sizes)[:-1]]
    return jnp.split(a, offs, axis=-1)


def dwconv_centred(u, w, b):
    width = w.shape[0]
    pad = width // 2
    L = u.shape[1]
    up = jnp.pad(u, ((0, 0), (pad, pad), (0, 0)))
    out = up[:, 0:L] * w[0]
    for k in range(1, width):
        out = out + up[:, k:k + L] * w[k]
    return out + b


def apply_rope(t, cos, sin):
    half = t.shape[-1] // 2
    t1 = t[..., :half].astype(jnp.float32)
    t2 = t[..., half:].astype(jnp.float32)
    return jnp.concatenate([t1 * cos - t2 * sin, t2 * cos + t1 * sin], axis=-1).astype(t.dtype)


def mla_mixer(cq_raw, ckv_raw, kr_raw, positions, q_norm, w_uq, kv_norm, w_ukv):
    b, l, _ = cq_raw.shape
    f32 = jnp.float32
    q = (rmsnorm(cq_raw, q_norm) @ w_uq).reshape(b, l, MLA_HEADS, MLA_NOPE + MLA_ROPE)
    kv = (rmsnorm(ckv_raw, kv_norm) @ w_ukv).reshape(b, l, MLA_HEADS, MLA_NOPE + MLA_V)
    q_nope, q_rope = q[..., :MLA_NOPE], q[..., MLA_NOPE:]
    k_nope, v = kv[..., :MLA_NOPE], kv[..., MLA_NOPE:]
    inv_freq = ROPE_THETA ** (-jnp.arange(0, MLA_ROPE, 2, dtype=f32) / MLA_ROPE)
    ang = positions.astype(f32)[..., None] * inv_freq
    cos, sin = jnp.cos(ang), jnp.sin(ang)
    q_rope = apply_rope(q_rope, cos[:, :, None], sin[:, :, None])
    k_rope = apply_rope(kr_raw, cos, sin)
    scale = (MLA_NOPE + MLA_ROPE) ** -0.5
    nb = l // Q_BLOCK

    def blocks(t):
        return jnp.moveaxis(t.reshape(b, nb, Q_BLOCK, *t.shape[2:]), 1, 0)

    def attend(qb):
        qn, qr = qb
        s = jnp.einsum('bqhd,bkhd->bhqk', qn, k_nope) + jnp.einsum('bqhr,bkr->bhqk', qr, k_rope)
        w = jax.nn.softmax(s.astype(f32) * scale, axis=-1).astype(v.dtype)
        return jnp.einsum('bhqk,bkhd->bqhd', w, v)

    o = lax.map(attend, (blocks(q_nope), blocks(q_rope)))
    return jnp.moveaxis(o, 0, 1).reshape(b, l, MLA_WIDTH)


def hyena_filters(L, w1, b1, freq, w2, b2, w3, decay):
    f32 = jnp.float32
    t = jnp.arange(L, dtype=f32) / L
    bands = jnp.arange(1, HY_BANDS + 1, dtype=f32)
    ang = 2.0 * math.pi * t[:, None] * bands[None, :]
    feats = jnp.concatenate([t[:, None], jnp.sin(ang), jnp.cos(ang)], axis=-1)
    fr = freq.astype(f32)
    hdn = jnp.sin(fr * (feats @ w1.astype(f32) + b1.astype(f32)))
    hdn = jnp.sin(fr * (hdn @ w2.astype(f32) + b2.astype(f32)))
    filt = hdn @ w3.astype(f32)
    window = jnp.exp(-t[:, None] * jnp.abs(decay.astype(f32))[None, :])
    return (filt * window).reshape(L, HY_ORDER, 2, HY_WIDTH)


def fftconv_bidir(u, k_fwd, k_bwd, bias):
    b, L, c = u.shape
    k2 = jnp.concatenate([k_fwd, jnp.zeros((1, c), k_fwd.dtype), k_bwd[1:][::-1]], axis=0)
    kf = jnp.fft.rfft(k2, n=2 * L, axis=0)
    uf = jnp.fft.rfft(u.astype(jnp.float32), n=2 * L, axis=1)
    y = jnp.fft.irfft(uf * kf[None], n=2 * L, axis=1)[:, :L]
    return (y + u.astype(jnp.float32) * bias.astype(jnp.float32)).astype(u.dtype)


def hyena_mixer(u_raw, conv_w, conv_b, w1, b1, freq, w2, b2, w3, decay, bias):
    L = u_raw.shape[1]
    u = dwconv_centred(u_raw, conv_w, conv_b)
    parts = jnp.split(u, HY_ORDER + 1, axis=-1)
    gates, v = parts[:-1], parts[-1]
    filt = hyena_filters(L, w1, b1, freq, w2, b2, w3, decay)
    for o in range(HY_ORDER):
        v = fftconv_bidir(v, filt[:, o, 0], filt[:, o, 1], bias[o]) * gates[o]
    return v


def ssd_scan(x, dt, a, bm, cm):
    f32 = jnp.float32
    b, l, h, pdim = x.shape
    n = bm.shape[-1]
    q = SSM_CHUNK
    nc = l // q
    xdt = (x.astype(f32) * dt[..., None]).reshape(b, nc, q, h, pdim)
    bc = bm.astype(f32).reshape(b, nc, q, h, n)
    cc = cm.astype(f32).reshape(b, nc, q, h, n)
    a_cs = jnp.cumsum((dt * a).reshape(b, nc, q, h), axis=2)
    seg = a_cs[:, :, :, None, :] - a_cs[:, :, None, :, :]
    lower = jnp.tril(jnp.ones((q, q), dtype=bool))[None, None, :, :, None]
    decay_in = jnp.exp(jnp.where(lower, seg, -jnp.inf))
    scores = jnp.einsum('bclhn,bcshn->bclsh', cc, bc) * decay_in
    y_diag = jnp.einsum('bclsh,bcshp->bclhp', scores, xdt)
    decay_to_end = jnp.exp(a_cs[:, :, -1:, :] - a_cs)
    chunk_states = jnp.einsum('bcshn,bcshp->bchpn', bc * decay_to_end[..., None], xdt)
    chunk_decay = jnp.exp(a_cs[:, :, -1, :])

    def step(state, inp):
        st, dec = inp
        return state * dec[..., None, None] + st, state

    init = jnp.zeros((b, h, pdim, n), f32)
    _, prev = lax.scan(step, init, (jnp.moveaxis(chunk_states, 1, 0), jnp.moveaxis(chunk_decay, 1, 0)))
    prev = jnp.moveaxis(prev, 0, 1)
    y_off = jnp.einsum('bclhn,bchpn->bclhp', cc * jnp.exp(a_cs)[..., None], prev)
    return (y_diag + y_off).reshape(b, l, h, pdim)


def ssd_mixer(z, xbc_raw, dt_raw, conv_w, conv_b, dt_bias, a_log, d_skip, norm_g):
    f32 = jnp.float32
    b, l, _ = z.shape
    xbc = jax.nn.silu(dwconv_centred(xbc_raw, conv_w, conv_b))
    xs, bm, cm = split_cols(xbc, (SSM_WIDTH, SSM_GROUPS * SSM_STATE, SSM_GROUPS * SSM_STATE))
    xs = xs.reshape(b, l, SSM_HEADS, SSM_HEADDIM)
    rep = SSM_HEADS // SSM_GROUPS
    bm = jnp.repeat(bm.reshape(b, l, SSM_GROUPS, SSM_STATE), rep, axis=2)
    cm = jnp.repeat(cm.reshape(b, l, SSM_GROUPS, SSM_STATE), rep, axis=2)
    dt = jax.nn.softplus(dt_raw.astype(f32).reshape(b, l, 2, SSM_HEADS) + dt_bias.astype(f32))
    a = -jnp.exp(a_log.astype(f32))
    y_f = ssd_scan(xs, dt[:, :, 0], a[0], bm, cm)
    flip = lambda t: jnp.flip(t, axis=1)
    y_b = flip(ssd_scan(flip(xs), flip(dt[:, :, 1]), a[1], flip(bm), flip(cm)))
    y = y_f + y_b + xs.astype(f32) * d_skip.astype(f32)[:, None]
    y = y.reshape(b, l, SSM_WIDTH) * jax.nn.silu(z.astype(f32))
    y = rmsnorm(y.reshape(b, l, SSM_GROUPS, SSM_WIDTH // SSM_GROUPS), norm_g.reshape(SSM_GROUPS, -1))
    return y.reshape(b, l, SSM_WIDTH).astype(z.dtype)


def ec_moe(h, router, w_gate, w_up, w_down):
    b, l, d = h.shape
    cap = EC_CAPACITY_FACTOR * l // N_EXPERTS
    aff = jax.nn.softmax((h @ router).astype(jnp.float32), axis=-1)
    g, idx = lax.top_k(jnp.swapaxes(aff, 1, 2), cap)
    xe = jax.vmap(lambda hb, ib: hb[ib])(h, idx)
    a = jnp.einsum('becd,edf->becf', xe, w_gate)
    u = jnp.einsum('becd,edf->becf', xe, w_up)
    ye = jnp.einsum('becf,efd->becd', jax.nn.silu(a) * u, w_down) * g[..., None].astype(h.dtype)
    return jax.vmap(lambda ib, yb: jnp.zeros((l, d), yb.dtype).at[ib.reshape(-1)].add(yb.reshape(-1, d)))(idx, ye)


def setup_inputs(seed: int = 0) -> dict:
    key = jax.random.key(seed)
    nk = iter(jax.random.split(key, 48))
    f32 = jnp.float32

    def nrm(shape, scale):
        return jax.random.normal(next(nk), shape, f32) * scale

    def gain(shape):
        return 1.0 + nrm(shape, 0.05)

    dt0 = jnp.exp(jax.random.uniform(next(nk), (DEPTH, 2, SSM_HEADS), f32, math.log(1e-3), math.log(1e-1)))
    decay0 = jnp.tile(jnp.linspace(HY_DECAY_MIN, HY_DECAY_MAX, HY_WIDTH, dtype=f32), HY_ORDER * 2)
    return {
        'x': nrm((BATCH, SEQ, D_MODEL), 1.0),
        'p': nrm((DEPTH, BATCH, SEQ, PLE_DIM), 1.0),
        'positions': jnp.broadcast_to(jnp.arange(SEQ, dtype=jnp.int32), (BATCH, SEQ)),
        'norm_mix': gain((DEPTH, D_MODEL)),
        'w_in': nrm((DEPTH, D_MODEL, N_IN), D_MODEL ** -0.5),
        'mla_q_norm': gain((DEPTH, MLA_Q_LORA)),
        'mla_w_uq': nrm((DEPTH, MLA_Q_LORA, MLA_HEADS * (MLA_NOPE + MLA_ROPE)), MLA_Q_LORA ** -0.5),
        'mla_kv_norm': gain((DEPTH, MLA_KV_LORA)),
        'mla_w_ukv': nrm((DEPTH, MLA_KV_LORA, MLA_HEADS * (MLA_NOPE + MLA_V)), MLA_KV_LORA ** -0.5),
        'mla_out_norm': gain((DEPTH, MLA_WIDTH)),
        'hy_conv_w': nrm((DEPTH, HY_SHORT, (HY_ORDER + 1) * HY_WIDTH), HY_SHORT ** -0.5),
        'hy_conv_b': nrm((DEPTH, (HY_ORDER + 1) * HY_WIDTH), 0.01),
        'hy_filt_w1': nrm((DEPTH, HY_POS_FEAT, HY_FILT_HID), HY_POS_FEAT ** -0.5),
        'hy_filt_b1': nrm((DEPTH, HY_FILT_HID), 0.01),
        'hy_filt_freq': gain((DEPTH, HY_FILT_HID)),
        'hy_filt_w2': nrm((DEPTH, HY_FILT_HID, HY_FILT_HID), HY_FILT_HID ** -0.5),
        'hy_filt_b2': nrm((DEPTH, HY_FILT_HID), 0.01),
        'hy_filt_w3': nrm((DEPTH, HY_FILT_HID, HY_ORDER * 2 * HY_WIDTH), HY_FILT_HID ** -0.5),
        'hy_decay': decay0[None, :] + nrm((DEPTH, HY_ORDER * 2 * HY_WIDTH), 0.1),
        'hy_bias': nrm((DEPTH, HY_ORDER, HY_WIDTH), 0.1),
        'hy_out_norm': gain((DEPTH, HY_WIDTH)),
        'ssm_conv_w': nrm((DEPTH, SSM_CONV, SSM_CONV_DIM), SSM_CONV ** -0.5),
        'ssm_conv_b': nrm((DEPTH, SSM_CONV_DIM), 0.01),
        'ssm_dt_bias': dt0 + jnp.log(-jnp.expm1(-dt0)),
        'ssm_a_log': jnp.log(jax.random.uniform(next(nk), (DEPTH, 2, SSM_HEADS), f32, 1.0, 16.0)),
        'ssm_d': gain((DEPTH, SSM_HEADS)),
        'ssm_norm': gain((DEPTH, SSM_WIDTH)),
        'w_out': nrm((DEPTH, D_MIX, D_MODEL), D_MIX ** -0.5),
        'norm_ffn': gain((DEPTH, D_MODEL)),
        'moe_router': nrm((DEPTH, D_MODEL, N_EXPERTS), D_MODEL ** -0.5),
        'moe_w_gate': nrm((DEPTH, N_EXPERTS, D_MODEL, EXPERT_FF), D_MODEL ** -0.5),
        'moe_w_up': nrm((DEPTH, N_EXPERTS, D_MODEL, EXPERT_FF), D_MODEL ** -0.5),
        'moe_w_down': nrm((DEPTH, N_EXPERTS, EXPERT_FF, D_MODEL), EXPERT_FF ** -0.5),
        'ple_norm': gain((DEPTH, D_MODEL)),
        'ple_gate_w': nrm((DEPTH, D_MODEL, D_MODEL), D_MODEL ** -0.5),
        'ple_proj': nrm((DEPTH, PLE_DIM, D_MODEL), PLE_DIM ** -0.5),
        'final_norm': gain((D_MODEL,)),
    }


def reference(x, p, positions, norm_mix, w_in, mla_q_norm, mla_w_uq, mla_kv_norm, mla_w_ukv, mla_out_norm,
              hy_conv_w, hy_conv_b, hy_filt_w1, hy_filt_b1, hy_filt_freq, hy_filt_w2, hy_filt_b2, hy_filt_w3,
              hy_decay, hy_bias, hy_out_norm, ssm_conv_w, ssm_conv_b, ssm_dt_bias, ssm_a_log, ssm_d, ssm_norm,
              w_out, norm_ffn, moe_router, moe_w_gate, moe_w_up, moe_w_down, ple_norm, ple_gate_w, ple_proj,
              final_norm):
    for i in range(DEPTH):
        h = rmsnorm(x, norm_mix[i])
        cq, ckv, kr, hy_u, z, xbc, dt_raw = split_cols(h @ w_in[i], IN_SPLITS)
        o_mla = rmsnorm(mla_mixer(cq, ckv, kr, positions, mla_q_norm[i], mla_w_uq[i], mla_kv_norm[i], mla_w_ukv[i]),
                        mla_out_norm[i])
        o_hy = rmsnorm(hyena_mixer(hy_u, hy_conv_w[i], hy_conv_b[i], hy_filt_w1[i], hy_filt_b1[i], hy_filt_freq[i],
                                   hy_filt_w2[i], hy_filt_b2[i], hy_filt_w3[i], hy_decay[i], hy_bias[i]),
                       hy_out_norm[i])
        o_ssm = ssd_mixer(z, xbc, dt_raw, ssm_conv_w[i], ssm_conv_b[i], ssm_dt_bias[i], ssm_a_log[i], ssm_d[i],
                          ssm_norm[i])
        x = x + jnp.concatenate([o_mla, o_hy, o_ssm], axis=-1) @ w_out[i]
        x = x + ec_moe(rmsnorm(x, norm_ffn[i]), moe_router[i], moe_w_gate[i], moe_w_up[i], moe_w_down[i])
        gate = jax.nn.sigmoid(rmsnorm(x, ple_norm[i]) @ ple_gate_w[i])
        x = x + (p[i] @ ple_proj[i]) * gate
    return rmsnorm(x, final_norm)
```

```cpp
#include <hip/hip_runtime.h>
#include <hip/hip_cooperative_groups.h>
#include <stdint.h>
#include <stdio.h>
#include <string.h>
namespace cg = cooperative_groups;

typedef unsigned short bf16_t;
using bf16x8 = __attribute__((ext_vector_type(8))) short;
using f32x4 = __attribute__((ext_vector_type(4))) float;
using u32x4 = __attribute__((ext_vector_type(4))) unsigned int;
using u32x2 = __attribute__((ext_vector_type(2))) unsigned int;
using f32x16 = __attribute__((ext_vector_type(16))) float;
using s16x4 = __attribute__((ext_vector_type(4))) short;
typedef __bf16 bf16v2_t __attribute__((ext_vector_type(2)));
typedef float f32v2_t __attribute__((ext_vector_type(2)));
typedef _Float16 h16x2 __attribute__((ext_vector_type(2)));
typedef _Float16 h16x8 __attribute__((ext_vector_type(8)));

constexpr int NB = 2, L = 8192, D = 1024, T = NB * L, DEPTH = 2;
constexpr int NIN = 2216, NINP = 2304;
constexpr int C_CQ = 0, C_CKV = 256, C_KR = 384, C_HY = 416, C_Z = 1184, C_XBC = 1440, C_DT = 2208;
constexpr int NE = 16, FF = 2048, CAP = 1024;
constexpr float EPS = 1e-6f;
constexpr int NTHREADS = 512;
constexpr int SMEM_USER = 139264;
constexpr int SMEM_BYTES = SMEM_USER + 16;

struct Params {
  const float* x; const float* p; const int* pos;
  const float* norm_mix; const float* w_in; const float* q_norm; const float* w_uq; const float* kv_norm; const float* w_ukv;
  const float* mla_out_norm; const float* hy_conv_w; const float* hy_conv_b; const float* hy_w1; const float* hy_b1; const float* hy_freq;
  const float* hy_w2; const float* hy_b2; const float* hy_w3; const float* hy_decay; const float* hy_bias; const float* hy_out_norm;
  const float* ssm_conv_w; const float* ssm_conv_b; const float* ssm_dt_bias; const float* ssm_a_log; const float* ssm_d; const float* ssm_norm;
  const float* w_out; const float* norm_ffn; const float* router; const float* w_gate; const float* w_up; const float* w_down;
  const float* ple_norm; const float* ple_gate_w; const float* ple_proj; const float* final_norm;
  float* out;
  bf16_t *Win_t, *Wuq_t, *Wukv_t, *Wout_t, *Wgu_t, *Wd_t, *Wpg_t, *Wpp_t;
  float* xcur; bf16_t* A1; float* proj; bf16_t* Aq; bf16_t* Akv; float* qraw; float* kvraw;
  bf16_t *Qb, *Kn, *Kr, *Vt; bf16_t* oattn; float* huT; _Float16* filtT; float *v1T, *ohyT; h16x2* KFb; float *xbc; bf16_t* xbcr; float* dtv; bf16_t* zbuf; float *yf, *yb; float *ssq_q, *ssq_kv; float *states, *cdec; bf16_t* prevb;
  unsigned* bar; float* affT; int* idx; int* tokslot; bf16_t* Ybuf; bf16_t* PPb; float* gsel; bf16_t* H; bf16_t* Ap; float* PP;
};

typedef const Params __attribute__((address_space(4)))* KP;

__device__ __forceinline__ int tid_() { int t = threadIdx.x; asm volatile("" : "+v"(t)); return t; }
__device__ __forceinline__ int bid_() { int b = blockIdx.x; asm volatile("" : "+s"(b)); return b; }
__device__ __forceinline__ int gdim_() { int b = gridDim.x; asm volatile("" : "+s"(b)); return b; }
#define LAUNDER_IDS const int TIDX = tid_(); const int BIDX = bid_(); const int GDIM = gdim_(); (void)TIDX; (void)BIDX; (void)GDIM;

__device__ __forceinline__ bf16_t f2bf(float f) {
  __bf16 h = (__bf16)f;
  return __builtin_bit_cast(bf16_t, h);
}
__device__ __forceinline__ uint32_t pack2(float a, float b) {
  f32v2_t v = {a, b};
  bf16v2_t r = __builtin_convertvector(v, bf16v2_t);
  return __builtin_bit_cast(uint32_t, r);
}
__device__ __forceinline__ f32x4 unpack4(u32x2 y) {
  f32x4 r = {__uint_as_float(y[0] << 16), __uint_as_float(y[0] & 0xffff0000u), __uint_as_float(y[1] << 16), __uint_as_float(y[1] & 0xffff0000u)};
  return r;
}
__device__ __forceinline__ float wave_sum(float v) {
#pragma unroll
  for (int o = 32; o; o >>= 1) v += __shfl_xor(v, o);
  return v;
}
__device__ __forceinline__ float sigmf(float a) { return __builtin_amdgcn_rcpf(1.f + __expf(-a)); }
__device__ __forceinline__ float siluf(float a) { return a * sigmf(a); }
__device__ __forceinline__ void rope_cs(int pos, int j, float& cs, float& sn) {
  float invf = exp2f(-(float)(2 * j) * (13.287712379549449f / 32.f));
  float ang = (float)pos * invf;
  double rev = (double)ang * 0.15915494309189535;
  rev -= floor(rev);
  float ar = (float)rev * 6.283185307179586f;
  cs = __cosf(ar);
  sn = __sinf(ar);
}


#define XB_TMO      128
#define XB_XCNT(j)  (256  + 64 * (j))
#define XB_XSUB(j)  (1280 + 64 * (j))
#define XB_XGEN(j)  (2304 + 64 * (j))
#define XB_TOP      3328
#define XB_TOPGEN   3392
#define XCD_BAR_WORDS 3456
#define XB_SPIN_CAP (1u << 20)
#define XLAS __attribute__((address_space(3)))
__device__ __forceinline__ unsigned xb_ld(unsigned* p)              { return __hip_atomic_load(p, __ATOMIC_RELAXED, __HIP_MEMORY_SCOPE_AGENT); }
__device__ __forceinline__ unsigned xb_add(unsigned* p, unsigned v) { return __hip_atomic_fetch_add(p, v, __ATOMIC_RELAXED, __HIP_MEMORY_SCOPE_AGENT); }
__device__ __forceinline__ unsigned xb_xcc_id() { return (unsigned)__builtin_amdgcn_s_getreg((3 << 11) | 20) & 0xFu; }
#define XB_SPIN(cond, bar) do { unsigned _sp = 0; while (cond) { __builtin_amdgcn_s_sleep(1); \
    if ((++_sp & 255u) == 0u) { if (xb_ld(&(bar)[XB_TMO])) break; if (_sp > XB_SPIN_CAP) { atomicAdd(&(bar)[XB_TMO], 1u); break; } } } } while (0)
struct XcdBarrier { unsigned* bar; unsigned x; volatile XLAS unsigned* st; };
__device__ __forceinline__ XcdBarrier xcd_barrier_post(unsigned* bar, volatile XLAS unsigned* st) {
  XcdBarrier b; b.bar = bar; b.x = xb_xcc_id(); b.st = st;
  if (threadIdx.x == 0) (void)xb_add(&bar[XB_XCNT(b.x)], 1u);
  return b;
}
__device__ __forceinline__ void xcd_barrier_complete(unsigned* bar, unsigned x, unsigned& nloc, unsigned& nx) {
  const unsigned G = gridDim.x * gridDim.y * gridDim.z;
  unsigned sum, cnt, mine, sp = 0u;
  for (;;) {
    sum = 0u; cnt = 0u; mine = 0u;
#pragma unroll
    for (unsigned j = 0; j < 16; ++j) { const unsigned c = xb_ld(&bar[XB_XCNT(j)]); sum += c; cnt += (c > 0u) ? 1u : 0u; mine = (j == x) ? c : mine; }
    if (sum == G) break;
    __builtin_amdgcn_s_sleep(1);
    if ((++sp & 255u) == 0u) { if (xb_ld(&bar[XB_TMO])) break; if (sp > XB_SPIN_CAP) { atomicAdd(&bar[XB_TMO], 1u); break; } }
  }
  nloc = mine > 0u ? mine : 1u; nx = cnt > 0u ? cnt : 1u;
}
__device__ __forceinline__ void xcd_barrier(const XcdBarrier& b) {
  asm volatile("s_waitcnt vmcnt(0)" ::: "memory");
  __syncthreads();
  if (threadIdx.x == 0) {
    unsigned* bar = b.bar;
    __builtin_amdgcn_s_waitcnt(0);
    unsigned nloc = b.st[0], nx = b.st[1];
    if (nloc == 0u) { xcd_barrier_complete(bar, b.x, nloc, nx); b.st[0] = nloc; b.st[1] = nx; }
    const unsigned old = xb_add(&bar[XB_XSUB(b.x)], 1u);
    const unsigned gen = old / nloc;
    if (old + 1u == (gen + 1u) * nloc) {
      __builtin_amdgcn_fence(__ATOMIC_RELEASE, "agent");
      asm volatile("s_waitcnt vmcnt(0)" ::: "memory");
      const unsigned og = xb_add(&bar[XB_TOP], 1u);
      const unsigned tg = og / nx;
      if (og + 1u == (tg + 1u) * nx) xb_add(&bar[XB_TOPGEN], 1u);
      else XB_SPIN(xb_ld(&bar[XB_TOPGEN]) == tg, bar);
      __builtin_amdgcn_fence(__ATOMIC_ACQUIRE, "agent");
      xb_add(&bar[XB_XGEN(b.x)], 1u);
      asm volatile("s_waitcnt vmcnt(0)" ::: "memory");
    } else {
      XB_SPIN(xb_ld(&bar[XB_XGEN(b.x)]) == gen, bar);
      __builtin_amdgcn_fence(__ATOMIC_ACQUIRE, "agent");
      asm volatile("s_waitcnt vmcnt(0)" ::: "memory");
    }
  }
  __syncthreads();
}

__device__ __forceinline__ void convert_T(const float* __restrict__ src, bf16_t* dst, int K, int N, int Npad, int batch, size_t sstride,
                          size_t dstride, int mode, float* tile) {
  LAUNDER_IDS
  const int kt = K / 64, nt = Npad / 64;
  const int total = batch * kt * nt;
  for (int t = BIDX; t < total; t += GDIM) {
    int bi = t / (kt * nt);
    int r = t % (kt * nt);
    int ki = r / nt, ni = r % nt;
    const float* s = src + (size_t)bi * sstride;
    bf16_t* d = dst + (size_t)bi * dstride;
    __syncthreads();
    for (int i = TIDX; i < 64 * 64; i += NTHREADS) {
      int kk = i >> 6, nn = i & 63;
      int n = ni * 64 + nn;
      tile[kk * 65 + nn] = (n < N) ? s[(size_t)(ki * 64 + kk) * N + n] : 0.f;
    }
    __syncthreads();
    for (int i = TIDX; i < 64 * 32; i += NTHREADS) {
      int nn = i >> 5, k2 = (i & 31) * 2;
      int n = ni * 64 + nn;
      const int cc_ = n & 31;
      const int rho_ = ((cc_ >> 2) & 1) * 16 + (cc_ >> 3) * 4 + (cc_ & 3);
      int drow;
      if (mode == 0) drow = n;
      else if (mode == 4) drow = (n & ~31) + rho_;
      else drow = (n >> 7) * 256 + ((mode == 2) ? 128 : 0) + ((n & 127) & ~31) + rho_;
      uint32_t pk = pack2(tile[k2 * 65 + nn], tile[(k2 + 1) * 65 + nn]);
      *(uint32_t*)(d + (size_t)drow * K + ki * 64 + k2) = pk;
    }
  }
}

__device__ __forceinline__ void convert_T2(const float* __restrict__ src, bf16_t* dst, int K, int N, int Npad, int batch, size_t sstride,
                           size_t dstride, int mode, char* sm, const float* __restrict__ gk = nullptr, int vb0 = 0, int vgrid = 0) {
  LAUNDER_IDS
  const int kt = K / 64, nt = Npad / 256;
  const int total = batch * kt * nt;
  const int n4 = TIDX & 63, kq = TIDX >> 6;
  const int VG = vgrid ? vgrid : GDIM;
  if (BIDX < vb0 || BIDX >= vb0 + VG) return;
  int t = BIDX - vb0;
  if (t >= total) return;
  f32x4 r[8];
#define CONV_LOAD(tt) do { int _bi = (tt) / (kt * nt); int _r = (tt) % (kt * nt); int _ki = _r / nt, _ni = _r % nt; const int _n = _ni * 256 + n4 * 4; \
    if (_n < N) { const float* sp = src + (size_t)_bi * sstride + (size_t)(_ki * 64 + kq * 4) * N + _n; \
      _Pragma("unroll") for (int _q = 0; _q < 4; ++_q) { r[_q] = __builtin_nontemporal_load((const f32x4*)(sp + (size_t)_q * N)); r[4 + _q] = __builtin_nontemporal_load((const f32x4*)(sp + (size_t)(32 + _q) * N)); } \
    } else { _Pragma("unroll") for (int _q = 0; _q < 8; ++_q) r[_q] = f32x4{0.f, 0.f, 0.f, 0.f}; } } while (0)
  CONV_LOAD(t);
  for (; t < total; t += VG) {
    int bi = t / (kt * nt);
    int rr = t % (kt * nt);
    int ki = rr / nt, ni = rr % nt;
    __syncthreads();
    if (gk) {
      f32x4 g0 = *(const f32x4*)(gk + ki * 64 + kq * 4), g1 = *(const f32x4*)(gk + ki * 64 + 32 + kq * 4);
#pragma unroll
      for (int q = 0; q < 4; ++q) { r[q] *= g0[q]; r[4 + q] *= g1[q]; }
    }
    const int key = n4 & 15;
#pragma unroll
    for (int j = 0; j < 4; ++j) {
      u32x2 v0 = {pack2(r[0][j], r[1][j]), pack2(r[2][j], r[3][j])};
      u32x2 v1 = {pack2(r[4][j], r[5][j]), pack2(r[6][j], r[7][j])};
      char* rowp = sm + (n4 * 4 + j) * 128;
      *(u32x2*)(rowp + ((kq ^ key) << 3)) = v0;
      *(u32x2*)(rowp + (((kq + 8) ^ key) << 3)) = v1;
    }
    __syncthreads();
    if (t + VG < total) CONV_LOAD(t + VG);
    bf16_t* d = dst + (size_t)bi * dstride;
#pragma unroll
    for (int c = TIDX; c < 2048; c += NTHREADS) {
      int row = c >> 3, ch = c & 7;
      const int key2 = (row >> 2) & 15;
      u32x2 a = *(const u32x2*)(sm + row * 128 + (((2 * ch) ^ key2) << 3));
      u32x2 bq = *(const u32x2*)(sm + row * 128 + (((2 * ch + 1) ^ key2) << 3));
      int n = ni * 256 + row;
      const int cc_ = n & 31;
      const int rho_ = ((cc_ >> 2) & 1) * 16 + (cc_ >> 3) * 4 + (cc_ & 3);
      int drow;
      if (mode == 0) drow = n;
      else if (mode == 4) drow = (n & ~31) + rho_;
      else drow = (n >> 7) * 256 + ((mode == 2) ? 128 : 0) + ((n & 127) & ~31) + rho_;
      u32x4 v = {a[0], a[1], bq[0], bq[1]};
      *(u32x4*)(d + (size_t)drow * K + ki * 64 + ch * 8) = v;
    }
  }
#undef CONV_LOAD
}

constexpr int BM = 256, BN = 128, BK = 64, LROW = 144;

template <int TMODE = 0, int NW16 = 4, class Epi>
__device__ __forceinline__ void gemm_tile(const bf16_t* A, int lda, const int* gidx, const bf16_t* Bt, int ldb, int K,
                                          char* smem, Epi epi) {
  LAUNDER_IDS
  const int tid = TIDX, lane = tid & 63, wid = __builtin_amdgcn_readfirstlane(tid >> 6);
  const int wr = wid >> 1, wc = wid & 1;
  const int fr = lane & 15, fq = lane >> 4;
  char* sA = smem;
  char* sB = smem + BM * LROW;
  const bf16_t* ap[4];
  int aoff[4];
#pragma unroll
  for (int i = 0; i < 4; ++i) {
    int cid = tid + NTHREADS * i;
    int row = cid >> 3, ch = cid & 7;
    int grow = gidx ? gidx[row] : row;
    ap[i] = A + (size_t)grow * lda + ch * 8;
    aoff[i] = row * LROW + ch * 16;
  }
  constexpr int NBL = NW16 / 2;
  const bf16_t* bp[NBL];
  int boff[NBL];
#pragma unroll
  for (int i = 0; i < NBL; ++i) {
    int cid = tid + NTHREADS * i;
    int row = cid >> 3, ch = cid & 7;
    bp[i] = Bt + (size_t)row * ldb + ch * 8;
    boff[i] = row * LROW + ch * 16;
  }
  u32x4 ra[4], rb[NBL];
#pragma unroll
  for (int i = 0; i < 4; ++i) ra[i] = *(const u32x4*)(ap[i]);
#pragma unroll
  for (int i = 0; i < NBL; ++i) rb[i] = *(const u32x4*)(bp[i]);
  f32x4 acc[4][NW16];
#pragma unroll
  for (int m = 0; m < 4; ++m)
#pragma unroll
    for (int n = 0; n < NW16; ++n) acc[m][n] = f32x4{0.f, 0.f, 0.f, 0.f};
  const int nk = K / BK;
  for (int kt = 0; kt < nk; ++kt) {
    __syncthreads();
#pragma unroll
    for (int i = 0; i < 4; ++i) *(u32x4*)(sA + aoff[i]) = ra[i];
#pragma unroll
    for (int i = 0; i < NBL; ++i) *(u32x4*)(sB + boff[i]) = rb[i];
    __syncthreads();
    {
      const int kn = (kt + 1 < nk) ? (kt + 1) : kt;
#pragma unroll
      for (int i = 0; i < 4; ++i) ra[i] = *(const u32x4*)(ap[i] + kn * BK);
#pragma unroll
      for (int i = 0; i < NBL; ++i) rb[i] = *(const u32x4*)(bp[i] + kn * BK);
    }
#pragma unroll
    for (int ks = 0; ks < 2; ++ks) {
      bf16x8 af[4];
#pragma unroll
      for (int m = 0; m < 4; ++m) af[m] = *(const bf16x8*)(sA + (wr * 64 + m * 16 + fr) * LROW + ks * 64 + fq * 16);
#pragma unroll
      for (int n0 = 0; n0 < NW16; n0 += 2) {
        bf16x8 bfr[2];
#pragma unroll
        for (int n = 0; n < 2; ++n) bfr[n] = *(const bf16x8*)(sB + (wc * (NW16 * 16) + (n0 + n) * 16 + fr) * LROW + ks * 64 + fq * 16);
        if (TMODE == 1 || (TMODE == 2 && wc == 0)) {
#pragma unroll
          for (int m = 0; m < 4; ++m)
#pragma unroll
            for (int n = 0; n < 2; ++n) acc[m][n0 + n] = __builtin_amdgcn_mfma_f32_16x16x32_bf16(bfr[n], af[m], acc[m][n0 + n], 0, 0, 0);
        } else {
#pragma unroll
          for (int m = 0; m < 4; ++m)
#pragma unroll
            for (int n = 0; n < 2; ++n) acc[m][n0 + n] = __builtin_amdgcn_mfma_f32_16x16x32_bf16(af[m], bfr[n], acc[m][n0 + n], 0, 0, 0);
        }
      }
    }
  }
  if constexpr (TMODE == 1) epi(acc, wr * 64 + fr, wc * (NW16 * 16) + fq * 4);
  else if constexpr (TMODE == 2) { if (wc == 0) epi.t(acc, wr * 64 + fr, fq * 4); else epi(acc, wr * 64 + fq * 4, wc * 64 + fr); }
  else epi(acc, wr * 64 + fq * 4, wc * 64 + fr);
}

namespace g8 {
#define G8_LAS __attribute__((address_space(3)))
constexpr int GBM = 256, GBK = 64, GHALF = 128, HTB = GHALF * GBK * 2, STAGE_BYTES = 8 * HTB;
__device__ __forceinline__ int lds_byte(int r, int c) { const int st = (r >> 4) * 2 + (c >> 5), rr = r & 15, cc = c & 31, ob = rr * 64 + cc * 2; return st * 1024 + (ob ^ (((ob >> 9) & 1) << 5)); }
__device__ __forceinline__ void stage_rc(int b, int& R, int& C) { const int st = b / 1024, sb = b % 1024, swz = sb ^ (((sb >> 9) & 1) << 5); R = (st >> 1) * 16 + swz / 64; C = (st & 1) * 32 + (swz % 64) / 2; }

struct Unit { const char* A; const char* B; int row0, col0, grp, gslot; };

template <bool GATHER, class Sched, class Epi>
__device__ __forceinline__ void gemm_phase(G8_LAS unsigned char* lds, const int K, const int lda, const int ldb, const Sched& S, const Epi& E, const int tid) {
  const int wid = __builtin_amdgcn_readfirstlane(tid >> 6), lane = tid & 63, wr = wid >> 2, wc = wid & 3, fr = lane & 15, fq = lane >> 4;
  const int nt = K / GBK;
  unsigned voffB[2];
#pragma unroll
  for (int i = 0; i < 2; ++i) { int R_, C_; stage_rc(tid * 16 + i * 8192, R_, C_); voffB[i] = (unsigned)(R_ * ldb + C_) * 2u; }
  const size_t kstep = (size_t)(GBK * 2);
  const size_t hstepB = (size_t)GHALF * ldb * 2;
  const unsigned ldsw = (unsigned)wid * 1024u;
  const int aoff = lds_byte(wr * 64 + fr, fq * 8), boff = lds_byte(wc * 32 + fr, fq * 8);
  const G8_LAS int* gl = (const G8_LAS int*)(lds + STAGE_BYTES);
#define G8_SA(b, h) (((b) * 2 + (h)) * HTB)
#define G8_SB(b, h) ((4 + (b) * 2 + (h)) * HTB)
#define G8_STAGE(bufoff, gbase, voff) do { _Pragma("unroll") for (int _i = 0; _i < 2; ++_i) \
    __builtin_amdgcn_global_load_lds((const unsigned*)((const char*)(gbase) + (voff)[_i]), (G8_LAS unsigned*)(lds + (bufoff) + ldsw + _i * 8192), 16, 0, 0); } while (0)
#define G8_LDA(dst, b, h) do { _Pragma("unroll") for (int m = 0; m < 4; ++m) _Pragma("unroll") for (int k = 0; k < 2; ++k) dst[m][k] = *(const G8_LAS bf16x8*)(lds + G8_SA(b, h) + aoff + m * 2048 + k * 1024); } while (0)
#define G8_LDB(dst, b, h) do { _Pragma("unroll") for (int n = 0; n < 2; ++n) _Pragma("unroll") for (int k = 0; k < 2; ++k) dst[n][k] = *(const G8_LAS bf16x8*)(lds + G8_SB(b, h) + boff + n * 2048 + k * 1024); } while (0)
#define G8_MMA(ai, bj, At, Bt) do { __builtin_amdgcn_s_setprio(1); _Pragma("unroll") for (int m = 0; m < 4; ++m) _Pragma("unroll") for (int n = 0; n < 2; ++n) _Pragma("unroll") for (int k = 0; k < 2; ++k) \
    acc[ai][bj][m][n] = __builtin_amdgcn_mfma_f32_16x16x32_bf16(Bt[n][k], At[m][k], acc[ai][bj][m][n], 0, 0, 0); __builtin_amdgcn_s_setprio(0); } while (0)
#define G8_WAIT_V(n) asm volatile("s_waitcnt vmcnt(" #n ")" ::: "memory")
#define G8_WAIT_L(n) asm volatile("s_waitcnt lgkmcnt(" #n ")" ::: "memory")
#define G8_BAR __builtin_amdgcn_s_barrier()
#define G8_SCHED __builtin_amdgcn_sched_barrier(0)
#define G8_AOFFS(dst, u) do { int _tl = tid; asm volatile("" : "+v"(_tl)); _Pragma("unroll") for (int _i = 0; _i < 2; ++_i) { int _R, _C; stage_rc(_tl * 16 + _i * 8192, _R, _C); \
    _Pragma("unroll") for (int _h = 0; _h < 2; ++_h) { int _row = _h * GHALF + _R; if (GATHER) _row = gl[(u).gslot * 256 + _row]; dst[_h][_i] = (unsigned)(_row * lda + _C) * 2u; } } } while (0)
  Unit cur, nxt;
  int ui = 0;
  if (!S.next(0, cur)) return;
  f32x4 acc[2][2][4][2];
#pragma unroll
  for (int a = 0; a < 2; ++a)
#pragma unroll
    for (int b = 0; b < 2; ++b)
#pragma unroll
      for (int m = 0; m < 4; ++m)
#pragma unroll
        for (int n = 0; n < 2; ++n) acc[a][b][m][n] = (f32x4){0.f, 0.f, 0.f, 0.f};
  bf16x8 At[4][2], B0[2][2], B1[2][2];
  unsigned vAc[2][2];
  G8_AOFFS(vAc, cur);
  const char* cA = cur.A;
  const char* cB = cur.B;
  G8_STAGE(G8_SB(0, 0), cB, voffB); G8_STAGE(G8_SA(0, 0), cA, vAc[0]); G8_STAGE(G8_SB(0, 1), cB + hstepB, voffB); G8_STAGE(G8_SA(0, 1), cA, vAc[1]);
  if (wr == 1) G8_BAR;
  G8_WAIT_V(4); G8_BAR;
  G8_STAGE(G8_SB(1, 0), cB + kstep, voffB); G8_STAGE(G8_SA(1, 0), cA + kstep, vAc[0]); G8_STAGE(G8_SB(1, 1), cB + hstepB + kstep, voffB);
  G8_WAIT_V(6); G8_BAR;
  for (;;) {
    bool has_next = false;
    const char* nA = cA;
    const char* nB = cB;
#pragma unroll 1
    for (int t = 0; t < nt; t += 2) {
      const bool last = (t == nt - 2);
      if (last) { has_next = S.next(ui + 1, nxt); if (has_next) { nA = nxt.A; nB = nxt.B; } }
      const char* a1 = cA + (size_t)(t + 1) * kstep;
      const char* a2 = last ? nA : cA + (size_t)(t + 2) * kstep;
      const char* b2 = last ? nB : cB + (size_t)(t + 2) * kstep;
      const char* a3 = a2 + kstep;
      const char* b3 = b2 + kstep;
      G8_LDB(B0, 0, 0); G8_SCHED; G8_LDA(At, 0, 0); G8_STAGE(G8_SA(1, 1), a1, vAc[1]);
      G8_WAIT_L(8); G8_BAR; G8_WAIT_L(0); G8_MMA(0, 0, At, B0); G8_BAR; G8_SCHED;
      if (last && has_next) { G8_AOFFS(vAc, nxt); }
      G8_LDB(B1, 0, 1); G8_STAGE(G8_SB(0, 0), b2, voffB);
      G8_BAR; G8_WAIT_L(0); G8_MMA(0, 1, At, B1); G8_BAR;
      G8_LDA(At, 0, 1); G8_STAGE(G8_SA(0, 0), a2, vAc[0]);
      G8_BAR; G8_WAIT_L(0); G8_MMA(1, 0, At, B0); G8_BAR; G8_SCHED;
      G8_STAGE(G8_SB(0, 1), b2 + hstepB, voffB);
      G8_WAIT_V(6); G8_BAR; G8_MMA(1, 1, At, B1); G8_BAR;
      G8_LDB(B0, 1, 0); G8_SCHED; G8_LDA(At, 1, 0); G8_STAGE(G8_SA(0, 1), a2, vAc[1]);
      G8_WAIT_L(8); G8_BAR; G8_WAIT_L(0); G8_MMA(0, 0, At, B0); G8_BAR; G8_SCHED;
      G8_LDB(B1, 1, 1); G8_STAGE(G8_SB(1, 0), b3, voffB);
      G8_BAR; G8_WAIT_L(0); G8_MMA(0, 1, At, B1); G8_BAR;
      G8_LDA(At, 1, 1); G8_STAGE(G8_SA(1, 0), a3, vAc[0]);
      G8_BAR; G8_WAIT_L(0); G8_MMA(1, 0, At, B0); G8_BAR; G8_SCHED;
      G8_STAGE(G8_SB(1, 1), b3 + hstepB, voffB);
      G8_WAIT_V(6); G8_BAR; G8_MMA(1, 1, At, B1); G8_BAR;
    }
    E(acc, cur, wr, wc, fr, fq);
    if (!has_next) break;
#pragma unroll
    for (int a = 0; a < 2; ++a)
#pragma unroll
      for (int b = 0; b < 2; ++b)
#pragma unroll
        for (int m = 0; m < 4; ++m)
#pragma unroll
          for (int n = 0; n < 2; ++n) acc[a][b][m][n] = (f32x4){0.f, 0.f, 0.f, 0.f};
    cur = nxt; cA = nA; cB = nB; ++ui;
  }
  G8_WAIT_V(0);
  if (wr == 0) G8_BAR;
  G8_BAR;
#undef G8_SA
#undef G8_SB
#undef G8_STAGE
#undef G8_LDA
#undef G8_LDB
#undef G8_MMA
#undef G8_WAIT_V
#undef G8_WAIT_L
#undef G8_BAR
#undef G8_SCHED
#undef G8_AOFFS
}

struct DenseSched {
  const char* A; const char* B; int lda, ldb, nM, nN, nwg, G, c;
  __device__ __forceinline__ bool next(int i, Unit& u) const {
    const long Lx = (long)i * G + c;
    if (Lx >= nwg) return false;
    int wgid = (int)Lx;
    { const int q = nwg / 8, r = nwg % 8, xcd = wgid % 8, off = wgid / 8; wgid = (xcd < r ? xcd * (q + 1) : r * (q + 1) + (xcd - r) * q) + off; }
    const int nig = 8 * nN, gid = wgid / nig, fm = gid * 8, gsz = (nM - fm) < 8 ? (nM - fm) : 8;
    const int pm = fm + ((wgid % nig) % gsz), pn = (wgid % nig) / gsz;
    u.A = A + (size_t)pm * GBM * lda * 2; u.B = B + (size_t)pn * GBM * ldb * 2; u.row0 = pm * GBM; u.col0 = pn * GBM; u.grp = 0; u.gslot = 0;
    return true;
  }
};
struct MoeSched {
  const char* A; const char* B; int lda, ldb, nN, rounds, G, c; size_t strideA_g, strideB_e; bool gather;
  __device__ __forceinline__ bool next(int i, Unit& u) const {
    const long Lx = (long)i * G + c;
    if (Lx >= (long)rounds * 256) return false;
    const int rnd = (int)(Lx >> 8), cc = (int)(Lx & 255);
    const int x = cc & 7, j = cc >> 3;
    const int bt = rnd * 32 + x * 4 + (j >> 3), bpm = j & 7;
    const int b = bpm >> 2, pm = bpm & 3;
    const int e = bt / nN, pn = bt % nN;
    const int grp = b * NE + e;
    u.A = gather ? (A + (size_t)b * L * lda * 2) : (A + (size_t)grp * strideA_g + (size_t)pm * GBM * lda * 2);
    u.B = B + (size_t)e * strideB_e + (size_t)pn * GBM * ldb * 2;
    u.row0 = pm * GBM; u.col0 = pn * GBM; u.grp = grp; u.gslot = i;
    return true;
  }
};

struct EpiStoreF32 {
  float* C; int ldc; int ncols;
  __device__ __forceinline__ void operator()(const f32x4 (&acc)[2][2][4][2], const Unit& u, int wr, int wc, int fr, int fq) const {
#pragma unroll
    for (int ai = 0; ai < 2; ++ai)
#pragma unroll
      for (int m = 0; m < 4; ++m) {
        const int row = u.row0 + ai * GHALF + wr * 64 + m * 16 + fr;
#pragma unroll
        for (int bj = 0; bj < 2; ++bj)
#pragma unroll
          for (int n = 0; n < 2; ++n) {
            const int col = u.col0 + bj * GHALF + wc * 32 + n * 16 + fq * 4;
            if (col < ncols) *(f32x4*)(C + (size_t)row * ldc + col) = acc[ai][bj][m][n];
          }
      }
  }
};
struct EpiInproj {
  KP P; int ly;
  __device__ __forceinline__ void operator()(const f32x4 (&acc)[2][2][4][2], const Unit& u, int wr, int wc, int fr, int fq) const {
    bf16_t* Aq = P->Aq; bf16_t* Akv = P->Akv; bf16_t* Kr = P->Kr; float* huT = P->huT; bf16_t* zbuf = P->zbuf; bf16_t* xbcr = P->xbcr; float* dtv = P->dtv;
    float* ssq_q = P->ssq_q; float* ssq_kv = P->ssq_kv; const int* pos = P->pos; const float* dtb = P->ssm_dt_bias + ly * 8;
    const int rbase = u.row0 + wr * 64 + fr;
    float sq[2][4];
#pragma unroll
    for (int ai = 0; ai < 2; ++ai)
#pragma unroll
      for (int m = 0; m < 4; ++m) sq[ai][m] = 0.f;
#pragma unroll
    for (int bj = 0; bj < 2; ++bj)
#pragma unroll
      for (int n = 0; n < 2; ++n) {
        const int cbase = u.col0 + bj * GHALF + wc * 32 + n * 16;
        const int c = cbase + fq * 4;
        if (cbase < C_KR) {
          bf16_t* dst = (cbase < C_CKV) ? (Aq + c) : (Akv + (c - C_CKV));
          const int ld = (cbase < C_CKV) ? 256 : 128;
#pragma unroll
          for (int ai = 0; ai < 2; ++ai)
#pragma unroll
            for (int m = 0; m < 4; ++m) {
              const int row = rbase + ai * GHALF + m * 16;
              const f32x4 v = acc[ai][bj][m][n];
              u32x2 o = {pack2(v[0], v[1]), pack2(v[2], v[3])};
              *(u32x2*)(dst + (size_t)row * ld) = o;
              sq[ai][m] += v[0] * v[0] + v[1] * v[1] + v[2] * v[2] + v[3] * v[3];
            }
        } else if (cbase < C_HY) {
        } else if (cbase < C_Z) {
#pragma unroll
          for (int ai = 0; ai < 2; ++ai)
#pragma unroll
            for (int m = 0; m < 4; ++m) {
              const int row = rbase + ai * GHALF + m * 16;
              const int b = row / L, l = row % L;
              const f32x4 v = acc[ai][bj][m][n];
              float* hp = huT + ((size_t)b * 768 + (c - C_HY)) * L + l;
              hp[0] = v[0]; hp[L] = v[1]; hp[2 * (size_t)L] = v[2]; hp[3 * (size_t)L] = v[3];
            }
        } else if (cbase < C_XBC) {
#pragma unroll
          for (int ai = 0; ai < 2; ++ai)
#pragma unroll
            for (int m = 0; m < 4; ++m) {
              const int row = rbase + ai * GHALF + m * 16;
              { const f32x4 v = acc[ai][bj][m][n]; u32x2 o = {pack2(v[0], v[1]), pack2(v[2], v[3])}; *(u32x2*)(zbuf + (size_t)row * 256 + (c - C_Z)) = o; }
            }
        } else if (cbase < C_DT) {
#pragma unroll
          for (int ai = 0; ai < 2; ++ai)
#pragma unroll
            for (int m = 0; m < 4; ++m) {
              const int row = rbase + ai * GHALF + m * 16;
              { const f32x4 v = acc[ai][bj][m][n]; u32x2 o = {pack2(v[0], v[1]), pack2(v[2], v[3])}; *(u32x2*)(xbcr + (size_t)row * 768 + (c - C_XBC)) = o; }
            }
        } else if (cbase == C_DT) {
          if (fq < 2) {
            const f32x4 bb = *(const f32x4*)(dtb + fq * 4);
#pragma unroll
            for (int ai = 0; ai < 2; ++ai)
#pragma unroll
              for (int m = 0; m < 4; ++m) {
                const int row = rbase + ai * GHALF + m * 16;
                const f32x4 v = acc[ai][bj][m][n];
                f32x4 o;
#pragma unroll
                for (int e = 0; e < 4; ++e) { float t = v[e] + bb[e]; o[e] = (t > 20.f) ? t : __logf(1.f + __expf(t)); }
                *(f32x4*)(dtv + (size_t)row * 8 + fq * 4) = o;
              }
          }
        }
      }
    if (u.col0 == 0 || u.col0 == 256) {
      float* sp = (u.col0 == 0) ? ssq_q : ssq_kv;
#pragma unroll
      for (int ai = 0; ai < 2; ++ai)
#pragma unroll
        for (int m = 0; m < 4; ++m) {
          float t = sq[ai][m];
          t += __shfl_xor(t, 16); t += __shfl_xor(t, 32);
          if (fq == 0) sp[(size_t)(rbase + ai * GHALF + m * 16) * 4 + wc] = t;
        }
    }
    if (u.col0 == 256 && wc == 0) {
#pragma unroll 1
      for (int e = 0; e < 4; ++e) {
        const int j = fq * 4 + e;
#pragma unroll
        for (int ai = 0; ai < 2; ++ai)
#pragma unroll
          for (int m = 0; m < 4; ++m) {
            const int row = rbase + ai * GHALF + m * 16;
            float cs, sn;
            rope_cs(pos[row], j, cs, sn);
            const f32x4 va = acc[ai][1][m][0], vb = acc[ai][1][m][1];
            const float k1 = (e == 0) ? va[0] : (e == 1) ? va[1] : (e == 2) ? va[2] : va[3];
            const float k2 = (e == 0) ? vb[0] : (e == 1) ? vb[1] : (e == 2) ? vb[2] : vb[3];
            Kr[(size_t)row * 32 + j] = f2bf(k1 * cs - k2 * sn);
            Kr[(size_t)row * 32 + 16 + j] = f2bf(k2 * cs + k1 * sn);
          }
      }
    }
  }
};
struct EpiStoreBf16 {
  bf16_t* C; int ldc;
  __device__ __forceinline__ void operator()(const f32x4 (&acc)[2][2][4][2], const Unit& u, int wr, int wc, int fr, int fq) const {
#pragma unroll
    for (int ai = 0; ai < 2; ++ai)
#pragma unroll
      for (int m = 0; m < 4; ++m) {
        const int row = u.row0 + ai * GHALF + wr * 64 + m * 16 + fr;
#pragma unroll
        for (int bj = 0; bj < 2; ++bj) {
          const int col = u.col0 + bj * GHALF + wc * 32 + fq * 8;
          const f32x4 a = acc[ai][bj][m][0], b = acc[ai][bj][m][1];
          u32x4 o = {pack2(a[0], a[1]), pack2(a[2], a[3]), pack2(b[0], b[1]), pack2(b[2], b[3])};
          *(u32x4*)(C + (size_t)row * ldc + col) = o;
        }
      }
  }
};
struct EpiResidF32 {
  float* X; const float* Xs;
  __device__ __forceinline__ void operator()(const f32x4 (&acc)[2][2][4][2], const Unit& u, int wr, int wc, int fr, int fq) const {
#pragma unroll
    for (int ai = 0; ai < 2; ++ai)
#pragma unroll
      for (int mh = 0; mh < 2; ++mh) {
        f32x4 xv[2][2][2];
#pragma unroll
        for (int mm = 0; mm < 2; ++mm)
#pragma unroll
          for (int bj = 0; bj < 2; ++bj)
#pragma unroll
            for (int n = 0; n < 2; ++n) {
              const int row = u.row0 + ai * GHALF + wr * 64 + (mh * 2 + mm) * 16 + fr;
              const int col = u.col0 + bj * GHALF + wc * 32 + n * 16 + fq * 4;
              xv[mm][bj][n] = *(const f32x4*)(Xs + (size_t)row * D + col);
            }
#pragma unroll
        for (int mm = 0; mm < 2; ++mm)
#pragma unroll
          for (int bj = 0; bj < 2; ++bj)
#pragma unroll
            for (int n = 0; n < 2; ++n) {
              const int row = u.row0 + ai * GHALF + wr * 64 + (mh * 2 + mm) * 16 + fr;
              const int col = u.col0 + bj * GHALF + wc * 32 + n * 16 + fq * 4;
              *(f32x4*)(X + (size_t)row * D + col) = xv[mm][bj][n] + acc[ai][bj][mh * 2 + mm][n];
            }
      }
  }
};
struct EpiPleF32 {
  float* X; const bf16_t* PP;
  __device__ __forceinline__ void operator()(const f32x4 (&acc)[2][2][4][2], const Unit& u, int wr, int wc, int fr, int fq) const {
#pragma unroll
    for (int ai = 0; ai < 2; ++ai)
#pragma unroll
      for (int mh = 0; mh < 2; ++mh) {
        f32x4 xv[2][2][2];
        u32x2 pq[2][2][2];
#pragma unroll
        for (int mm = 0; mm < 2; ++mm)
#pragma unroll
          for (int bj = 0; bj < 2; ++bj)
#pragma unroll
            for (int n = 0; n < 2; ++n) {
              const int row = u.row0 + ai * GHALF + wr * 64 + (mh * 2 + mm) * 16 + fr;
              const int col = u.col0 + bj * GHALF + wc * 32 + n * 16 + fq * 4;
              const size_t o = (size_t)row * D + col;
              pq[mm][bj][n] = *(const u32x2*)(PP + o);
              xv[mm][bj][n] = *(const f32x4*)(X + o);
            }
#pragma unroll
        for (int mm = 0; mm < 2; ++mm)
#pragma unroll
          for (int bj = 0; bj < 2; ++bj)
#pragma unroll
            for (int n = 0; n < 2; ++n) {
              const int row = u.row0 + ai * GHALF + wr * 64 + (mh * 2 + mm) * 16 + fr;
              const int col = u.col0 + bj * GHALF + wc * 32 + n * 16 + fq * 4;
              const f32x4 pp = unpack4(pq[mm][bj][n]);
              const f32x4 a = acc[ai][bj][mh * 2 + mm][n];
              f32x4 r = xv[mm][bj][n];
#pragma unroll
              for (int j = 0; j < 4; ++j) r[j] += pp[j] * sigmf(a[j]);
              *(f32x4*)(X + (size_t)row * D + col) = r;
            }
      }
  }
};
struct EpiSwigluBf16 {
  bf16_t* H;
  __device__ __forceinline__ void operator()(const f32x4 (&acc)[2][2][4][2], const Unit& u, int wr, int wc, int fr, int fq) const {
    bf16_t* Hg = H + (size_t)u.grp * CAP * FF;
    const int hcol = (u.col0 >> 1) + wc * 32 + fq * 8;
#pragma unroll
    for (int ai = 0; ai < 2; ++ai)
#pragma unroll
      for (int m = 0; m < 4; ++m) {
        const int row = u.row0 + ai * GHALF + wr * 64 + m * 16 + fr;
        const f32x4 g0 = acc[ai][0][m][0], g1 = acc[ai][0][m][1], u0 = acc[ai][1][m][0], u1 = acc[ai][1][m][1];
        u32x4 o = {pack2(siluf(g0[0]) * u0[0], siluf(g0[1]) * u0[1]), pack2(siluf(g0[2]) * u0[2], siluf(g0[3]) * u0[3]),
                   pack2(siluf(g1[0]) * u1[0], siluf(g1[1]) * u1[1]), pack2(siluf(g1[2]) * u1[2], siluf(g1[3]) * u1[3])};
        *(u32x4*)(Hg + (size_t)row * FF + hcol) = o;
      }
  }
};
struct EpiMoeDownY {
  bf16_t* Y; const float* gs;
  __device__ __forceinline__ void operator()(const f32x4 (&acc)[2][2][4][2], const Unit& u, int wr, int wc, int fr, int fq) const {
    bf16_t* Yg = Y + (size_t)u.grp * CAP * D;
    const float* gg = gs + u.grp * CAP;
#pragma unroll
    for (int ai = 0; ai < 2; ++ai)
#pragma unroll
      for (int m = 0; m < 4; ++m) {
        const int row = u.row0 + ai * GHALF + wr * 64 + m * 16 + fr;
        const float g = gg[row];
#pragma unroll
        for (int bj = 0; bj < 2; ++bj) {
          const int col = u.col0 + bj * GHALF + wc * 32 + fq * 8;
          const f32x4 a = acc[ai][bj][m][0], b = acc[ai][bj][m][1];
          u32x4 o = {pack2(g * a[0], g * a[1]), pack2(g * a[2], g * a[3]), pack2(g * b[0], g * b[1]), pack2(g * b[2], g * b[3])};
          *(u32x4*)(Yg + (size_t)row * D + col) = o;
        }
      }
  }
};
}

template <int NC>
__device__ __forceinline__ void rms_row_bf16(const float* xr, const float* __restrict__ g, bf16_t* yr, int lane) {
  constexpr int IT = (NC + 255) / 256;
  float4 v[IT];
  float ss = 0.f;
#pragma unroll
  for (int i = 0; i < IT; ++i) {
    int c = i * 256 + lane * 4;
    if (c < NC) {
      v[i] = *(const float4*)(xr + c);
      ss += v[i].x * v[i].x + v[i].y * v[i].y + v[i].z * v[i].z + v[i].w * v[i].w;
    }
  }
  ss = wave_sum(ss);
  float rs = rsqrtf(ss * (1.f / NC) + EPS);
#pragma unroll
  for (int i = 0; i < IT; ++i) {
    int c = i * 256 + lane * 4;
    if (c < NC) {
      float4 g4 = *(const float4*)(g + c);
      uint2 o;
      o.x = pack2(v[i].x * rs * g4.x, v[i].y * rs * g4.y);
      o.y = pack2(v[i].z * rs * g4.z, v[i].w * rs * g4.w);
      *(uint2*)(yr + c) = o;
    }
  }
}

__device__ __forceinline__ void phase_convert_gu(KP P, int ly, char* sm) {
  convert_T2(P->w_gate + (size_t)ly * NE * D * FF, P->Wgu_t, D, FF, FF, NE, (size_t)D * FF, (size_t)2 * FF * D, 1, sm, nullptr, 32, 224);
  convert_T2(P->w_up + (size_t)ly * NE * D * FF, P->Wgu_t, D, FF, FF, NE, (size_t)D * FF, (size_t)2 * FF * D, 2, sm, nullptr, 32, 224);
}
__device__ __forceinline__ void phase_convert(KP P, int ly, float* tile) {
  convert_T2(P->w_in + (size_t)ly * D * NIN, P->Win_t, D, NIN, NINP, 1, 0, 0, 0, (char*)tile);
  convert_T2(P->w_uq + (size_t)ly * 256 * 768, P->Wuq_t, 256, 768, 768, 1, 0, 0, 0, (char*)tile, P->q_norm + ly * 256);
  convert_T2(P->w_ukv + (size_t)ly * 128 * 1024, P->Wukv_t, 128, 1024, 1024, 1, 0, 0, 0, (char*)tile, P->kv_norm + ly * 128);
  convert_T2(P->w_out + (size_t)ly * D * D, P->Wout_t, D, D, D, 1, 0, 0, 0, (char*)tile);
  convert_T2(P->w_down + (size_t)ly * NE * FF * D, P->Wd_t, FF, D, D, NE, (size_t)FF * D, (size_t)D * FF, 4, (char*)tile);
  convert_T2(P->ple_gate_w + (size_t)ly * D * D, P->Wpg_t, D, D, D, 1, 0, 0, 0, (char*)tile);
  convert_T2(P->ple_proj + (size_t)ly * 256 * D, P->Wpp_t, 256, D, D, 1, 0, 0, 4, (char*)tile);
}

__device__ __forceinline__ void phase_filters(KP P, int ly, float* sm, int vb0) {
  LAUNDER_IDS
  const int VB = BIDX - vb0, VG = GDIM - vb0;
  float* h1 = sm;
  float* h2 = sm + 64 * 65;
  float* sw2 = h2 + 64 * 65;
  float* sw1 = sw2 + 64 * 64;
  float* wsl = sw1 + 17 * 64;
  const float* w1 = P->hy_w1 + ly * 17 * 64;
  const float* b1 = P->hy_b1 + ly * 64;
  const float* fr = P->hy_freq + ly * 64;
  const float* w2 = P->hy_w2 + ly * 64 * 64;
  const float* b2 = P->hy_b2 + ly * 64;
  const float* w3 = P->hy_w3 + (size_t)ly * 64 * 1024;
  const float* dec = P->hy_decay + ly * 1024;
  const int tid = TIDX, lane = tid & 63, wid = tid >> 6;
  if (VB < 0 || VB >= L / 64) return;
  __syncthreads();
  for (int i = tid; i < 64 * 64; i += NTHREADS) sw2[i] = w2[i];
  for (int i = tid; i < 17 * 64; i += NTHREADS) sw1[i] = w1[i];
  for (int tb = VB; tb < L / 64; tb += VG) {
    const int tl = lane, jg = wid;
    float tt = (float)(tb * 64 + tl) / (float)L;
    __syncthreads();
    {
      float feats[17];
      feats[0] = tt;
#pragma unroll
      for (int b = 0; b < 8; ++b) {
        float rev = tt * (float)(b + 1);
        feats[1 + b] = __builtin_amdgcn_sinf(rev);
        feats[9 + b] = __builtin_amdgcn_cosf(rev);
      }
#pragma unroll
      for (int jj = 0; jj < 8; ++jj) {
        int j = jg * 8 + jj;
        float a = b1[j];
#pragma unroll
        for (int f = 0; f < 17; ++f) a += feats[f] * sw1[f * 64 + j];
        h1[tl * 65 + j] = __sinf(fr[j] * a);
      }
    }
    __syncthreads();
    {
      float a[8];
#pragma unroll
      for (int jj = 0; jj < 8; ++jj) a[jj] = b2[jg * 8 + jj];
      for (int k = 0; k < 64; ++k) {
        float hv = h1[tl * 65 + k];
        f32x4 wa = *(const f32x4*)(sw2 + k * 64 + jg * 8), wb = *(const f32x4*)(sw2 + k * 64 + jg * 8 + 4);
        a[0] += hv * wa[0]; a[1] += hv * wa[1]; a[2] += hv * wa[2]; a[3] += hv * wa[3];
        a[4] += hv * wb[0]; a[5] += hv * wb[1]; a[6] += hv * wb[2]; a[7] += hv * wb[3];
      }
#pragma unroll
      for (int jj = 0; jj < 8; ++jj) h2[tl * 65 + jg * 8 + jj] = __sinf(fr[jg * 8 + jj] * a[jj]);
    }
    __syncthreads();
    float* wb_ = wsl + wid * 512;
#pragma unroll 1
    for (int c0 = jg * 128; c0 < jg * 128 + 128; c0 += 8) {
      {
        f32x4 x0 = *(const f32x4*)(w3 + (size_t)lane * 1024 + c0), x1 = *(const f32x4*)(w3 + (size_t)lane * 1024 + c0 + 4);
        *(f32x4*)(wb_ + lane * 8) = x0; *(f32x4*)(wb_ + lane * 8 + 4) = x1;
      }
      float a[8];
#pragma unroll
      for (int jj = 0; jj < 8; ++jj) a[jj] = 0.f;
      for (int k = 0; k < 64; ++k) {
        float hv = h2[tl * 65 + k];
        f32x4 wa = *(const f32x4*)(wb_ + k * 8), wb2 = *(const f32x4*)(wb_ + k * 8 + 4);
        a[0] += hv * wa[0]; a[1] += hv * wa[1]; a[2] += hv * wa[2]; a[3] += hv * wa[3];
        a[4] += hv * wb2[0]; a[5] += hv * wb2[1]; a[6] += hv * wb2[2]; a[7] += hv * wb2[3];
      }
#pragma unroll
      for (int jj = 0; jj < 8; ++jj) {
        float win = __expf(-tt * fabsf(dec[c0 + jj]));
        P->filtT[(size_t)(c0 + jj) * L + tb * 64 + tl] = (_Float16)(a[jj] * win);
      }
    }
  }
}

__device__ __forceinline__ void phase_copy_x(KP P) {
  LAUNDER_IDS
  const float4* s = (const float4*)P->x;
  float4* d = (float4*)P->xcur;
  const int n = T * D / 4;
  for (int i = BIDX * NTHREADS + TIDX; i < n; i += GDIM * NTHREADS) d[i] = s[i];
}

__device__ __forceinline__ void phase_rms_x(KP P, const float* xsrc, const float* g, bf16_t* dst) {
  LAUNDER_IDS
  const int lane = TIDX & 63;
  const int gw = BIDX * 8 + (TIDX >> 6), nw = GDIM * 8;
  if (gw >= T) return;
  f32x4 cur[4], nx[4];
#pragma unroll
  for (int i = 0; i < 4; ++i) cur[i] = *(const f32x4*)(xsrc + (size_t)gw * D + i * 256 + lane * 4);
  for (int row = gw; row < T; row += nw) {
    const int nr = (row + nw < T) ? (row + nw) : row;
#pragma unroll
    for (int i = 0; i < 4; ++i) nx[i] = *(const f32x4*)(xsrc + (size_t)nr * D + i * 256 + lane * 4);
    float ss = 0.f;
#pragma unroll
    for (int i = 0; i < 4; ++i) ss += cur[i][0] * cur[i][0] + cur[i][1] * cur[i][1] + cur[i][2] * cur[i][2] + cur[i][3] * cur[i][3];
    ss = wave_sum(ss);
    const float rs = rsqrtf(ss * (1.f / D) + EPS);
#pragma unroll
    for (int i = 0; i < 4; ++i) {
      const int c = i * 256 + lane * 4;
      f32x4 g4 = *(const f32x4*)(g + c);
      u32x2 o = {pack2(cur[i][0] * rs * g4[0], cur[i][1] * rs * g4[1]), pack2(cur[i][2] * rs * g4[2], cur[i][3] * rs * g4[3])};
      *(u32x2*)(dst + (size_t)row * D + c) = o;
    }
#pragma unroll
    for (int i = 0; i < 4; ++i) cur[i] = nx[i];
  }
}

struct EpiStore {
  float* C; int ldc; int N; int row0; int col0;
  __device__ __forceinline__ void operator()(f32x4 (&acc)[4][4], int rb, int cb) const {
#pragma unroll
    for (int m = 0; m < 4; ++m)
#pragma unroll
      for (int n = 0; n < 4; ++n)
#pragma unroll
        for (int j = 0; j < 4; ++j) {
          int row = row0 + rb + m * 16 + j, col = col0 + cb + n * 16;
          if (col < N) C[(size_t)row * ldc + col] = acc[m][n][j];
        }
  }
};
struct EpiResid {
  float* X; int row0; int col0;
  __device__ __forceinline__ void operator()(f32x4 (&acc)[4][4], int rb, int cb) const {
#pragma unroll
    for (int m = 0; m < 4; ++m)
#pragma unroll
      for (int n = 0; n < 4; ++n)
#pragma unroll
        for (int j = 0; j < 4; ++j) {
          int row = row0 + rb + m * 16 + j, col = col0 + cb + n * 16;
          X[(size_t)row * D + col] += acc[m][n][j];
        }
  }
};
struct EpiPle {
  float* X; const float* PP; int row0; int col0;
  __device__ __forceinline__ void operator()(f32x4 (&acc)[4][4], int rb, int cb) const {
#pragma unroll
    for (int m = 0; m < 4; ++m)
#pragma unroll
      for (int n = 0; n < 4; ++n)
#pragma unroll
        for (int j = 0; j < 4; ++j) {
          int row = row0 + rb + m * 16 + j, col = col0 + cb + n * 16;
          size_t o = (size_t)row * D + col;
          float gte = 1.f / (1.f + __expf(-acc[m][n][j]));
          X[o] += PP[o] * gte;
        }
  }
};
struct EpiSwiglu {
  bf16_t* H; int row0; int hcol0;
  __device__ __forceinline__ void operator()(f32x4 (&acc)[4][4], int rb, int cb) const {
    int wc64 = cb & 64, fr = cb & 15;
#pragma unroll
    for (int m = 0; m < 4; ++m)
#pragma unroll
      for (int n = 0; n < 2; ++n)
#pragma unroll
        for (int j = 0; j < 4; ++j) {
          int row = row0 + rb + m * 16 + j;
          int col = hcol0 + (wc64 >> 1) + n * 16 + fr;
          float a = acc[m][n][j], u = acc[m][n + 2][j];
          H[(size_t)row * FF + col] = f2bf(siluf(a) * u);
        }
  }
};
struct EpiMoeDown {
  float* Xb; const int* idx; const float* gs; int row0; int col0;
  __device__ __forceinline__ void operator()(f32x4 (&acc)[4][4], int rb, int cb) const {
#pragma unroll
    for (int m = 0; m < 4; ++m)
#pragma unroll
      for (int j = 0; j < 4; ++j) {
        int row = row0 + rb + m * 16 + j;
        int tok = idx[row];
        float g = gs[row];
#pragma unroll
        for (int n = 0; n < 4; ++n) {
          int col = col0 + cb + n * 16;
          unsafeAtomicAdd(&Xb[(size_t)tok * D + col], g * acc[m][n][j]);
        }
      }
  }
};

struct EpiQ {
  bf16_t* Qb; const float* ssq; const int* pos; int row0; int col0;
  __device__ __forceinline__ void operator()(f32x4 (&acc)[4][6], int rb, int cb) const {
    const float qs = 0.14724445f;
    const int fq4 = cb & 15, wcb = cb - fq4;
    const int h = (col0 + wcb) / 96;
#pragma unroll
    for (int m = 0; m < 4; ++m) {
      const int row = row0 + rb + m * 16;
      const int b = row / L, l = row % L;
      const f32x4 sp4 = *(const f32x4*)(ssq + (size_t)row * 4);
      const float rs = rsqrtf(((sp4[0] + sp4[1]) + (sp4[2] + sp4[3])) * (1.f / 256.f) + EPS) * qs;
      bf16_t* Q = Qb + (((size_t)(b * 8 + h)) * L + l) * 96 + fq4;
#pragma unroll
      for (int n = 0; n < 4; ++n) {
        const f32x4 v = acc[m][n];
        u32x2 o = {pack2(v[0] * rs, v[1] * rs), pack2(v[2] * rs, v[3] * rs)};
        *(u32x2*)(Q + n * 16) = o;
      }
      const int pp = pos[row];
      float o1[4], o2[4];
#pragma unroll
      for (int j = 0; j < 4; ++j) {
        float cs, sn;
        rope_cs(pp, fq4 + j, cs, sn);
        const float t1 = acc[m][4][j] * rs, t2 = acc[m][5][j] * rs;
        o1[j] = t1 * cs - t2 * sn;
        o2[j] = t2 * cs + t1 * sn;
      }
      u32x2 w1 = {pack2(o1[0], o1[1]), pack2(o1[2], o1[3])};
      u32x2 w2 = {pack2(o2[0], o2[1]), pack2(o2[2], o2[3])};
      *(u32x2*)(Q + 64) = w1;
      *(u32x2*)(Q + 80) = w2;
    }
  }
};
struct EpiKV {
  bf16_t* Kn; bf16_t* Vt; const float* ssq; int row0; int col0;
  __device__ __forceinline__ void t(f32x4 (&acc)[4][4], int rb, int fq4) const {
    const int h = col0 >> 7;
    f32x4 spq[4];
#pragma unroll
    for (int m = 0; m < 4; ++m) spq[m] = *(const f32x4*)(ssq + (size_t)(row0 + rb + m * 16) * 4);
#pragma unroll
    for (int m = 0; m < 4; ++m) {
      const int row = row0 + rb + m * 16;
      const int b = row / L, lb = row % L;
      const f32x4 sp4 = spq[m];
      const float rs = rsqrtf(((sp4[0] + sp4[1]) + (sp4[2] + sp4[3])) * (1.f / 128.f) + EPS);
      bf16_t* kp = Kn + (((size_t)(b * 8 + h)) * L + lb) * 64 + fq4;
#pragma unroll
      for (int n = 0; n < 4; ++n) {
        const f32x4 v = acc[m][n];
        u32x2 o = {pack2(v[0] * rs, v[1] * rs), pack2(v[2] * rs, v[3] * rs)};
        *(u32x2*)(kp + n * 16) = o;
      }
    }
  }
  __device__ __forceinline__ void operator()(f32x4 (&acc)[4][4], int rb, int cb) const {
    const int fr = cb & 15, wcb = cb - fr;
    float rsq[4][4];
#pragma unroll
    for (int m = 0; m < 4; ++m)
#pragma unroll
      for (int j = 0; j < 4; ++j) { const f32x4 sp4 = *(const f32x4*)(ssq + (size_t)(row0 + rb + m * 16 + j) * 4); rsq[m][j] = rsqrtf(((sp4[0] + sp4[1]) + (sp4[2] + sp4[3])) * (1.f / 128.f) + EPS); }
#pragma unroll
    for (int m = 0; m < 4; ++m) {
      const int rowb = row0 + rb + m * 16;
      const int b = rowb / L, lb = rowb % L;
      float rs[4];
#pragma unroll
      for (int j = 0; j < 4; ++j) rs[j] = rsq[m][j];
#pragma unroll
      for (int n = 0; n < 4; ++n) {
        const int c0 = col0 + wcb + n * 16;
        const int h = c0 >> 7, cc0 = c0 & 127;
        if (cc0 < 64) {
#pragma unroll
          for (int j = 0; j < 4; ++j) Kn[(((size_t)(b * 8 + h)) * L + lb + j) * 64 + cc0 + fr] = f2bf(acc[m][n][j] * rs[j]);
        } else {
          u32x2 o = {pack2(acc[m][n][0] * rs[0], acc[m][n][1] * rs[1]), pack2(acc[m][n][2] * rs[2], acc[m][n][3] * rs[3])};
          const int lbp = (lb & ~12) | ((lb & 4) << 1) | ((lb & 8) >> 1);
          *(u32x2*)(Vt + (((size_t)(b * 8 + h)) * 64 + (cc0 - 64 + fr)) * L + lbp) = o;
        }
      }
    }
  }
};
__device__ __forceinline__ void phase_gemm_inproj(KP P, char* smem) {
  LAUNDER_IDS
  constexpr int NT = NINP / BN;
  for (int t = BIDX; t < (T / BM) * NT; t += GDIM) {
    int mi = t / NT, ni = t % NT;
    EpiStore e{P->proj, NIN, NIN, mi * BM, ni * BN};
    gemm_tile(P->A1 + (size_t)mi * BM * D, D, nullptr, P->Win_t + (size_t)ni * BN * D, D, D, smem, e);
  }
}
__device__ __forceinline__ void phase_gemm_qkv(KP P, char* smem) {
  LAUNDER_IDS
  constexpr int NTQ = 768 / 192, NTK = 1024 / BN;
  constexpr int TQ = (T / BM) * NTQ, TK = (T / BM) * NTK;
  for (int t = BIDX; t < TQ + TK; t += GDIM) {
    if (t < TQ) {
      int mi = t / NTQ, ni = t % NTQ;
      EpiQ e{P->Qb, P->ssq_q, P->pos, mi * BM, ni * 192};
      gemm_tile<1, 6>(P->Aq + (size_t)mi * BM * 256, 256, nullptr, P->Wuq_t + (size_t)ni * 192 * 256, 256, 256, smem, e);
    } else {
      int u = t - TQ;
      int mi = u / NTK, ni = u % NTK;
      EpiKV e{P->Kn, P->Vt, P->ssq_kv, mi * BM, ni * BN};
      gemm_tile<2>(P->Akv + (size_t)mi * BM * 128, 128, nullptr, P->Wukv_t + (size_t)ni * BN * 128, 128, 128, smem, e);
    }
  }
}
__device__ __forceinline__ void phase_gemm_out(KP P, char* smem) {
  LAUNDER_IDS
  constexpr int NT = D / BN;
  for (int t = BIDX; t < (T / BM) * NT; t += GDIM) {
    int mi = t / NT, ni = t % NT;
    EpiResid e{P->xcur, mi * BM, ni * BN};
    gemm_tile(P->A1 + (size_t)mi * BM * D, D, nullptr, P->Wout_t + (size_t)ni * BN * D, D, D, smem, e);
  }
}
__device__ __forceinline__ void phase_gemm_pp(KP P, char* smem) {
  LAUNDER_IDS
  constexpr int NT = D / BN;
  for (int t = BIDX; t < (T / BM) * NT; t += GDIM) {
    int mi = t / NT, ni = t % NT;
    EpiStore e{P->PP, D, D, mi * BM, ni * BN};
    gemm_tile(P->Ap + (size_t)mi * BM * 256, 256, nullptr, P->Wpp_t + (size_t)ni * BN * 256, 256, 256, smem, e);
  }
}
__device__ __forceinline__ void phase_gemm_ple(KP P, char* smem) {
  LAUNDER_IDS
  constexpr int NT = D / BN;
  for (int t = BIDX; t < (T / BM) * NT; t += GDIM) {
    int mi = t / NT, ni = t % NT;
    EpiPle e{P->xcur, P->PP, mi * BM, ni * BN};
    gemm_tile(P->A1 + (size_t)mi * BM * D, D, nullptr, P->Wpg_t + (size_t)ni * BN * D, D, D, smem, e);
  }
}
__device__ __forceinline__ void phase_moe1(KP P, char* smem) {
  LAUNDER_IDS
  for (int t = BIDX; t < 16 * 32 * 2 * 4; t += GDIM) {
    int mt = t & 3, b = (t >> 2) & 1, ni = (t >> 3) & 31, e = t >> 8;
    int g = b * NE + e;
    EpiSwiglu ep{P->H + (size_t)g * CAP * FF, mt * BM, ni * (BN / 2)};
    gemm_tile(P->A1 + (size_t)b * L * D, D, P->idx + g * CAP + mt * BM, P->Wgu_t + ((size_t)e * 2 * FF + ni * BN) * D, D, D, smem, ep);
  }
}
__device__ __forceinline__ void phase_moe2(KP P, char* smem) {
  LAUNDER_IDS
  for (int t = BIDX; t < 16 * 8 * 2 * 4; t += GDIM) {
    int mt = t & 3, b = (t >> 2) & 1, ni = (t >> 3) & 7, e = t >> 6;
    int g = b * NE + e;
    EpiMoeDown ep{P->xcur + (size_t)b * L * D, P->idx + g * CAP, P->gsel + g * CAP, mt * BM, ni * BN};
    gemm_tile(P->H + ((size_t)g * CAP + mt * BM) * FF, FF, nullptr, P->Wd_t + ((size_t)e * D + ni * BN) * FF, FF, FF, smem, ep);
  }
}

__device__ __forceinline__ void phase_g8_inproj(KP P, int ly, char* smem) {
  LAUNDER_IDS
  __syncthreads();
  g8::DenseSched S{(const char*)P->A1, (const char*)P->Win_t, D, D, T / 256, NINP / 256, (T / 256) * (NINP / 256), GDIM, BIDX};
  g8::EpiInproj E{P, ly};
  g8::gemm_phase<false>((G8_LAS unsigned char*)smem, D, D, D, S, E, TIDX);
}
__device__ __forceinline__ void phase_g8_out(KP P, int ly, char* smem) {
  LAUNDER_IDS
  __syncthreads();
  g8::DenseSched S{(const char*)P->A1, (const char*)P->Wout_t, D, D, T / 256, D / 256, (T / 256) * (D / 256), GDIM, BIDX};
  g8::EpiResidF32 E{P->xcur, (ly == 0) ? P->x : P->xcur};
  g8::gemm_phase<false>((G8_LAS unsigned char*)smem, D, D, D, S, E, TIDX);
}
__device__ __forceinline__ void phase_g8_pp(KP P, char* smem) {
  LAUNDER_IDS
  __syncthreads();
  g8::DenseSched S{(const char*)P->Ap, (const char*)P->Wpp_t, 256, 256, T / 256, D / 256, (T / 256) * (D / 256), GDIM, BIDX};
  g8::EpiStoreBf16 E{P->PPb, D};
  g8::gemm_phase<false>((G8_LAS unsigned char*)smem, 256, 256, 256, S, E, TIDX);
}
__device__ __forceinline__ void phase_g8_ple(KP P, char* smem) {
  LAUNDER_IDS
  __syncthreads();
  g8::DenseSched S{(const char*)P->A1, (const char*)P->Wpg_t, D, D, T / 256, D / 256, (T / 256) * (D / 256), GDIM, BIDX};
  g8::EpiPleF32 E{P->xcur, P->PPb};
  g8::gemm_phase<false>((G8_LAS unsigned char*)smem, D, D, D, S, E, TIDX);
}
__device__ __forceinline__ void phase_g8_moe1(KP P, char* smem) {
  LAUNDER_IDS
  __syncthreads();
  g8::MoeSched S{(const char*)P->A1, (const char*)P->Wgu_t, D, D, 16, 8, GDIM, BIDX, 0, (size_t)2 * FF * D * 2, true};
  {
    int* gl = (int*)(smem + g8::STAGE_BYTES);
    g8::Unit u;
    for (int i = 0; i < 8; ++i) {
      if (!S.next(i, u)) break;
      if (TIDX < 256) gl[i * 256 + TIDX] = P->idx[u.grp * CAP + u.row0 + TIDX];
    }
    __syncthreads();
  }
  g8::EpiSwigluBf16 E{P->H};
  g8::gemm_phase<true>((G8_LAS unsigned char*)smem, D, D, D, S, E, TIDX);
}
__device__ __forceinline__ void phase_g8_moe2(KP P, char* smem) {
  LAUNDER_IDS
  __syncthreads();
  g8::MoeSched S{(const char*)P->H, (const char*)P->Wd_t, FF, FF, 4, 2, GDIM, BIDX, (size_t)CAP * FF * 2, (size_t)D * FF * 2, false};
  g8::EpiMoeDownY E{P->Ybuf, P->gsel};
  g8::gemm_phase<false>((G8_LAS unsigned char*)smem, FF, FF, FF, S, E, TIDX);
}

__device__ __forceinline__ void phase_prep2(KP P, int ly, float* sm) {
  LAUNDER_IDS
  const float* cw = P->ssm_conv_w + ly * 5 * 768;
  const float* cb = P->ssm_conv_b + ly * 768;
  for (int i = BIDX * NTHREADS + TIDX; i < T * 192; i += GDIM * NTHREADS) {
    const int row = i / 192, c = (i % 192) * 4;
    const int l = row & (L - 1);
    f32x4 a = *(const f32x4*)(cb + c);
#pragma unroll
    for (int k = 0; k < 5; ++k) {
      const int ll = l + k - 2;
      if (ll >= 0 && ll < L) {
        f32x4 w = *(const f32x4*)(cw + k * 768 + c);
        f32x4 x = unpack4(*(const u32x2*)(P->xbcr + (size_t)(row + k - 2) * 768 + c));
        a += w * x;
      }
    }
    f32x4 o = {siluf(a[0]), siluf(a[1]), siluf(a[2]), siluf(a[3])};
    *(f32x4*)(P->xbc + (size_t)row * 768 + c) = o;
  }
}

__device__ __forceinline__ void hyena_conv_item(const float* vin, const float* kf, const float* kb, float bias, const float* gate, float* outp,
                                int t0, float* sm) {
  LAUNDER_IDS
  float* vs = sm;
  float* kw = sm + 512;
  const int tid = TIDX;
  float acc = 0.f;
  for (int s0 = 0; s0 < L; s0 += 512) {
    __syncthreads();
    vs[tid] = vin[s0 + tid];
    for (int i = tid; i < 1023; i += NTHREADS) {
      int d = t0 - s0 - 511 + i;
      kw[i] = (d >= 0) ? kf[d] : kb[-d];
    }
    __syncthreads();
#pragma unroll 4
    for (int j = 0; j < 512; j += 4) {
      float4 v4 = *(const float4*)(vs + j);
      int base = tid + 511 - j;
      acc += kw[base] * v4.x + kw[base - 1] * v4.y + kw[base - 2] * v4.z + kw[base - 3] * v4.w;
    }
  }
  int t = t0 + tid;
  outp[t] = (acc + bias * vin[t]) * gate[t];
}
__device__ __forceinline__ void phase_hyena_conv(KP P, int ly, int order, float* sm) {
  LAUNDER_IDS
  for (int it = BIDX; it < NB * 256 * 16; it += GDIM) {
    int tb = it & 15, c = (it >> 4) & 255, b = it >> 12;
    const float* vin = (order == 0) ? (P->huT + ((size_t)b * 768 + 512 + c) * L) : (P->v1T + ((size_t)b * 256 + c) * L);
    const float* kf = (const float*)P->filtT + (size_t)(order * 512 + c) * L;
    const float* kb = (const float*)P->filtT + (size_t)(order * 512 + 256 + c) * L;
    float bias = P->hy_bias[ly * 512 + order * 256 + c];
    const float* gate = P->huT + ((size_t)b * 768 + order * 256 + c) * L;
    float* outp = (order == 0) ? (P->v1T + ((size_t)b * 256 + c) * L) : (P->ohyT + ((size_t)b * 256 + c) * L);
    hyena_conv_item(vin, kf, kb, bias, gate, outp, tb * 512, sm);
  }
}

constexpr int FFT_N = 16384;
constexpr int FFT_LDS_BYTES = (FFT_N + FFT_N / 16) * 8;
__device__ __forceinline__ int PH(int i) { return i + (i >> 4); }

__device__ __forceinline__ void dif16(float (&xr)[16], float (&xi)[16]) {
  constexpr float C16[8] = {1.f, 0.9238795325112867f, 0.7071067811865476f, 0.3826834323650898f, 0.f, -0.3826834323650898f, -0.7071067811865476f, -0.9238795325112867f};
  constexpr float S16[8] = {0.f, 0.3826834323650898f, 0.7071067811865476f, 0.9238795325112867f, 1.f, 0.9238795325112867f, 0.7071067811865476f, 0.3826834323650898f};
#pragma unroll
  for (int half = 8; half >= 1; half >>= 1) {
#pragma unroll
    for (int g = 0; g < 16; g += 2 * half) {
#pragma unroll
      for (int j = 0; j < half; ++j) {
        const int k = j * (8 / half);
        const float c = C16[k], sn = S16[k];
        float ar = xr[g + j], ai = xi[g + j], br = xr[g + j + half], bi = xi[g + j + half];
        xr[g + j] = ar + br; xi[g + j] = ai + bi;
        float dr = ar - br, di = ai - bi;
        xr[g + j + half] = dr * c + di * sn;
        xi[g + j + half] = di * c - dr * sn;
      }
    }
  }
}
__device__ __forceinline__ void dit16(float (&xr)[16], float (&xi)[16]) {
  constexpr float C16[8] = {1.f, 0.9238795325112867f, 0.7071067811865476f, 0.3826834323650898f, 0.f, -0.3826834323650898f, -0.7071067811865476f, -0.9238795325112867f};
  constexpr float S16[8] = {0.f, 0.3826834323650898f, 0.7071067811865476f, 0.9238795325112867f, 1.f, 0.9238795325112867f, 0.7071067811865476f, 0.3826834323650898f};
#pragma unroll
  for (int half = 1; half <= 8; half <<= 1) {
#pragma unroll
    for (int g = 0; g < 16; g += 2 * half) {
#pragma unroll
      for (int j = 0; j < half; ++j) {
        const int k = j * (8 / half);
        const float c = C16[k], sn = S16[k];
        float ar = xr[g + j], ai = xi[g + j], br0 = xr[g + j + half], bi0 = xi[g + j + half];
        float br = br0 * c - bi0 * sn;
        float bi = bi0 * c + br0 * sn;
        xr[g + j] = ar + br; xi[g + j] = ai + bi;
        xr[g + j + half] = ar - br; xi[g + j + half] = ai - bi;
      }
    }
  }
}
__device__ __forceinline__ void twiddle16(float (&xr)[16], float (&xi)[16], float er, float ei) {
  constexpr int BR4[16] = {0, 8, 4, 12, 2, 10, 6, 14, 1, 9, 5, 13, 3, 11, 7, 15};
  float pr = er, pi = ei;
#pragma unroll
  for (int q = 1; q < 16; ++q) {
    const int mp = BR4[q];
    float tr = xr[mp] * pr - xi[mp] * pi;
    float ti = xr[mp] * pi + xi[mp] * pr;
    xr[mp] = tr; xi[mp] = ti;
    if (q < 15) {
      float nr = pr * er - pi * ei;
      float ni = pr * ei + pi * er;
      pr = nr; pi = ni;
    }
  }
}
template <int B, int S>
__device__ __forceinline__ void fft_store16(float2* lds, int w, const float (&xr)[16], const float (&xi)[16]) {
  const int base = (w / S) * B + (w % S);
#pragma unroll
  for (int m = 0; m < 16; ++m) lds[PH(base + m * S)] = make_float2(xr[m], xi[m]);
}
template <int B, int S>
__device__ __forceinline__ void fft_load16(const float2* lds, int w, float (&xr)[16], float (&xi)[16]) {
  const int base = (w / S) * B + (w % S);
#pragma unroll
  for (int m = 0; m < 16; ++m) { float2 v = lds[PH(base + m * S)]; xr[m] = v.x; xi[m] = v.y; }
}
template <int B, int S>
__device__ __forceinline__ void fwd16(int w, float (&xr)[16], float (&xi)[16]) {
  dif16(xr, xi);
  const float rev = (float)(w % S) * (1.f / (float)B);
  twiddle16(xr, xi, __builtin_amdgcn_cosf(rev), -__builtin_amdgcn_sinf(rev));
}
template <int B, int S>
__device__ __forceinline__ void inv16(int w, float (&xr)[16], float (&xi)[16]) {
  const float rev = (float)(w % S) * (1.f / (float)B);
  twiddle16(xr, xi, __builtin_amdgcn_cosf(rev), __builtin_amdgcn_sinf(rev));
  dit16(xr, xi);
}
template <int B, int S, bool INV>
__device__ __forceinline__ void fft_pass16(float2* lds, int tid) {
  for (int w = tid; w < FFT_N / 16; w += NTHREADS) {
    float xr[16], xi[16];
    fft_load16<B, S>(lds, w, xr, xi);
    if (INV) inv16<B, S>(w, xr, xi); else fwd16<B, S>(w, xr, xi);
    fft_store16<B, S>(lds, w, xr, xi);
  }
}
__device__ __forceinline__ void fft_pass4(float2* lds, const h16x2* KF, int tid) {
  for (int w = tid; w < FFT_N / 4; w += NTHREADS) {
    const int p0 = PH(4 * w);
    float2 x0 = lds[p0], x1 = lds[p0 + 1], x2 = lds[p0 + 2], x3 = lds[p0 + 3];
    float2 a0 = make_float2(x0.x + x2.x, x0.y + x2.y), a2 = make_float2(x0.x - x2.x, x0.y - x2.y);
    float2 a1 = make_float2(x1.x + x3.x, x1.y + x3.y), d = make_float2(x1.x - x3.x, x1.y - x3.y);
    float2 a3 = make_float2(d.y, -d.x);
    float2 y0 = make_float2(a0.x + a1.x, a0.y + a1.y), y1 = make_float2(a0.x - a1.x, a0.y - a1.y);
    float2 y2 = make_float2(a2.x + a3.x, a2.y + a3.y), y3 = make_float2(a2.x - a3.x, a2.y - a3.y);
    if (KF) {
      const h16x8 kh = *(const h16x8*)(KF + 4 * w);
      constexpr float KS = 16.f / (float)FFT_N;
      float4 k01 = make_float4((float)kh[0] * KS, (float)kh[1] * KS, (float)kh[2] * KS, (float)kh[3] * KS);
      float4 k23 = make_float4((float)kh[4] * KS, (float)kh[5] * KS, (float)kh[6] * KS, (float)kh[7] * KS);
      float2 t;
      t = make_float2(y0.x * k01.x - y0.y * k01.y, y0.x * k01.y + y0.y * k01.x); y0 = t;
      t = make_float2(y1.x * k01.z - y1.y * k01.w, y1.x * k01.w + y1.y * k01.z); y1 = t;
      t = make_float2(y2.x * k23.x - y2.y * k23.y, y2.x * k23.y + y2.y * k23.x); y2 = t;
      t = make_float2(y3.x * k23.z - y3.y * k23.w, y3.x * k23.w + y3.y * k23.z); y3 = t;
      float2 b0 = make_float2(y0.x + y1.x, y0.y + y1.y), b1 = make_float2(y0.x - y1.x, y0.y - y1.y);
      float2 b2 = make_float2(y2.x + y3.x, y2.y + y3.y), b3 = make_float2(y2.x - y3.x, y2.y - y3.y);
      float2 b3i = make_float2(-b3.y, b3.x);
      y0 = make_float2(b0.x + b2.x, b0.y + b2.y);
      y2 = make_float2(b0.x - b2.x, b0.y - b2.y);
      y1 = make_float2(b1.x + b3i.x, b1.y + b3i.y);
      y3 = make_float2(b1.x - b3i.x, b1.y - b3i.y);
    }
    lds[p0] = y0; lds[p0 + 1] = y1; lds[p0 + 2] = y2; lds[p0 + 3] = y3;
  }
}

__device__ __forceinline__ void phase_hyena_fft(KP P, int ly, float2* lds) {
  LAUNDER_IDS
  const int tid = TIDX;
  for (int c = BIDX; c < 256; c += GDIM) {
    h16x2* KF0 = P->KFb + ((size_t)c * 2 + 0) * FFT_N;
    h16x2* KF1 = P->KFb + ((size_t)c * 2 + 1) * FFT_N;
    {
      const _Float16* f0 = P->filtT + (size_t)(0 + c) * L;
      const _Float16* b0 = P->filtT + (size_t)(256 + c) * L;
      const _Float16* f1 = P->filtT + (size_t)(512 + c) * L;
      const _Float16* b1 = P->filtT + (size_t)(768 + c) * L;
      __syncthreads();
      for (int w = tid; w < 1024; w += NTHREADS) {
        float xr[16], xi[16];
#pragma unroll
        for (int m = 0; m < 16; ++m) {
          const int n = m * 1024 + w;
          if (m < 8) { xr[m] = f0[n]; xi[m] = f1[n]; }
          else if (n == L) { xr[m] = 0.f; xi[m] = 0.f; }
          else { xr[m] = b0[FFT_N - n]; xi[m] = b1[FFT_N - n]; }
        }
        fwd16<16384, 1024>(w, xr, xi);
        fft_store16<16384, 1024>(lds, w, xr, xi);
      }
      __syncthreads();
      fft_pass16<1024, 64, false>(lds, tid);
      __syncthreads();
      fft_pass16<64, 4, false>(lds, tid);
      __syncthreads();
      fft_pass4(lds, nullptr, tid);
      __syncthreads();
      const float sc = 0.5f / 16.f;
      for (int pos = tid; pos < FFT_N; pos += NTHREADS) {
        int f = (int)(__brev((unsigned)pos) >> 18);
        int fp = (FFT_N - f) & (FFT_N - 1);
        int posp = (int)(__brev((unsigned)fp) >> 18);
        float2 W = lds[PH(pos)], Wp = lds[PH(posp)];
        float sr = W.x + Wp.x, si = W.y - Wp.y;
        float dr = W.x - Wp.x, di = W.y + Wp.y;
        KF0[pos] = h16x2{(_Float16)(sr * sc), (_Float16)(si * sc)};
        KF1[pos] = h16x2{(_Float16)(di * sc), (_Float16)(-dr * sc)};
      }
      __threadfence_block();
      __syncthreads();
    }
    const float bias0 = P->hy_bias[ly * 512 + c], bias1 = P->hy_bias[ly * 512 + 256 + c];
    const float* hw = P->hy_conv_w + ly * 3 * 768;
    const float* hb = P->hy_conv_b + ly * 768;
    const float wv0 = hw[512 + c], wv1 = hw[768 + 512 + c], wv2 = hw[1536 + 512 + c], bv = hb[512 + c];
    const float wa0 = hw[c], wa1 = hw[768 + c], wa2 = hw[1536 + c], ba = hb[c];
    const float wb0 = hw[256 + c], wb1 = hw[768 + 256 + c], wb2 = hw[1536 + 256 + c], bb = hb[256 + c];
    const float* rv0 = P->huT + ((size_t)0 * 768 + 512 + c) * L;
    const float* rv1 = P->huT + ((size_t)1 * 768 + 512 + c) * L;
    const float* ra0 = P->huT + ((size_t)0 * 768 + c) * L;
    const float* ra1 = P->huT + ((size_t)1 * 768 + c) * L;
    const float* rb0 = P->huT + ((size_t)0 * 768 + 256 + c) * L;
    const float* rb1 = P->huT + ((size_t)1 * 768 + 256 + c) * L;
#define HCONV(ptr, n, w0, w1, w2, bq) ((w0) * ((n) > 0 ? (ptr)[(n) - 1] : 0.f) + (w1) * (ptr)[(n)] + (w2) * ((n) < L - 1 ? (ptr)[(n) + 1] : 0.f) + (bq))
    float* v10 = P->v1T + ((size_t)0 * 256 + c) * L;
    float* v11 = P->v1T + ((size_t)1 * 256 + c) * L;
    float* o0 = P->ohyT + ((size_t)0 * 256 + c) * L;
    float* o1 = P->ohyT + ((size_t)1 * 256 + c) * L;
    for (int w = tid; w < 1024; w += NTHREADS) {
      float xr[16], xi[16];
#pragma unroll
      for (int m = 0; m < 16; ++m) {
        if (m < 8) { const int n = m * 1024 + w; xr[m] = HCONV(rv0, n, wv0, wv1, wv2, bv); xi[m] = HCONV(rv1, n, wv0, wv1, wv2, bv); }
        else { xr[m] = 0.f; xi[m] = 0.f; }
      }
      fwd16<16384, 1024>(w, xr, xi);
      fft_store16<16384, 1024>(lds, w, xr, xi);
    }
    __syncthreads();
    fft_pass16<1024, 64, false>(lds, tid);
    __syncthreads();
    fft_pass16<64, 4, false>(lds, tid);
    __syncthreads();
    fft_pass4(lds, KF0, tid);
    __syncthreads();
    fft_pass16<64, 4, true>(lds, tid);
    __syncthreads();
    fft_pass16<1024, 64, true>(lds, tid);
    __syncthreads();
    for (int w = tid; w < 1024; w += NTHREADS) {
      float xr[16], xi[16];
      fft_load16<16384, 1024>(lds, w, xr, xi);
      inv16<16384, 1024>(w, xr, xi);
      float hv0[8], hv1[8], ha0[8], ha1[8];
#pragma unroll
      for (int m = 0; m < 8; ++m) {
        const int n = m * 1024 + w;
        hv0[m] = HCONV(rv0, n, wv0, wv1, wv2, bv); hv1[m] = HCONV(rv1, n, wv0, wv1, wv2, bv);
        ha0[m] = HCONV(ra0, n, wa0, wa1, wa2, ba); ha1[m] = HCONV(ra1, n, wa0, wa1, wa2, ba);
      }
#pragma unroll
      for (int m = 0; m < 16; ++m) {
        if (m < 8) {
          const int n = m * 1024 + w;
          float a = (xr[m] + bias0 * hv0[m]) * ha0[m];
          float bq = (xi[m] + bias0 * hv1[m]) * ha1[m];
          v10[n] = a; v11[n] = bq;
          xr[m] = a; xi[m] = bq;
        } else { xr[m] = 0.f; xi[m] = 0.f; }
      }
      fwd16<16384, 1024>(w, xr, xi);
      fft_store16<16384, 1024>(lds, w, xr, xi);
    }
    __syncthreads();
    fft_pass16<1024, 64, false>(lds, tid);
    __syncthreads();
    fft_pass16<64, 4, false>(lds, tid);
    __syncthreads();
    fft_pass4(lds, KF1, tid);
    __syncthreads();
    fft_pass16<64, 4, true>(lds, tid);
    __syncthreads();
    fft_pass16<1024, 64, true>(lds, tid);
    __syncthreads();
    for (int w = tid; w < 1024; w += NTHREADS) {
      float xr[16], xi[16];
      fft_load16<16384, 1024>(lds, w, xr, xi);
      inv16<16384, 1024>(w, xr, xi);
      float pv0[8], pv1[8], hb0[8], hb1[8];
#pragma unroll
      for (int m = 0; m < 8; ++m) {
        const int n = m * 1024 + w;
        pv0[m] = v10[n]; pv1[m] = v11[n];
        hb0[m] = HCONV(rb0, n, wb0, wb1, wb2, bb); hb1[m] = HCONV(rb1, n, wb0, wb1, wb2, bb);
      }
#pragma unroll
      for (int m = 0; m < 8; ++m) {
        const int n = m * 1024 + w;
        o0[n] = (xr[m] + bias1 * pv0[m]) * hb0[m];
        o1[n] = (xi[m] + bias1 * pv1[m]) * hb1[m];
      }
    }
    __syncthreads();
  }
}

constexpr int SROW = 272;
constexpr int SMAT = 128 * SROW;
template <int MT, int NT, int K>
__device__ __forceinline__ void lds_mma(const char* sA, const char* sB, int arow0, int brow0, f32x4 (&acc)[MT][NT], int fr, int fq) {
#pragma unroll
  for (int k0 = 0; k0 < K; k0 += 32) {
    bf16x8 af[MT], bfr[NT];
#pragma unroll
    for (int m = 0; m < MT; ++m) af[m] = *(const bf16x8*)(sA + (arow0 + m * 16 + fr) * SROW + (k0 + fq * 8) * 2);
#pragma unroll
    for (int n = 0; n < NT; ++n) bfr[n] = *(const bf16x8*)(sB + (brow0 + n * 16 + fr) * SROW + (k0 + fq * 8) * 2);
#pragma unroll
    for (int m = 0; m < MT; ++m)
#pragma unroll
      for (int n = 0; n < NT; ++n) acc[m][n] = __builtin_amdgcn_mfma_f32_16x16x32_bf16(af[m], bfr[n], acc[m][n], 0, 0, 0);
  }
}
__device__ __forceinline__ void ssd_cumsum(const float* dtv, size_t row0, int col, float a, int dir, int lane, float* sAcs, float* sdt) {
  float d0 = dtv[(row0 + 2 * lane) * 8 + col], d1 = dtv[(row0 + 2 * lane + 1) * 8 + col];
  float incl = (d0 + d1) * a;
#pragma unroll
  for (int o = 1; o < 64; o <<= 1) {
    float v = __shfl_up(incl, o);
    if (lane >= o) incl += v;
  }
  float tot = __shfl(incl, 63);
  float acs0, acs1;
  if (dir == 0) { acs0 = incl - d1 * a; acs1 = incl; }
  else { acs0 = tot - (incl - d1 * a) + d0 * a; acs1 = tot - incl + d1 * a; }
  sAcs[2 * lane] = acs0; sAcs[2 * lane + 1] = acs1;
  sdt[2 * lane] = d0; sdt[2 * lane + 1] = d1;
  if (lane == 0) sAcs[128] = tot;
}

__device__ __forceinline__ void phase_ssd1(KP P, int ly, char* smem) {
  LAUNDER_IDS
  const int tid = TIDX, lane = tid & 63, wid = tid >> 6, fr = lane & 15, fq = lane >> 4;
  char* sC = smem;
  char* sB = smem + SMAT;
  char* sBT = smem + 2 * SMAT;
  float* sAcs4 = (float*)(smem + 3 * SMAT);
  for (int it = BIDX; it < 256; it += GDIM) {
    const int g = it & 1, c = (it >> 1) & 63, b = it >> 7;
    const size_t row0 = (size_t)b * L + c * 128;
    __syncthreads();
    {
      const float* cw = P->ssm_conv_w + ly * 5 * 768;
      const float* cb = P->ssm_conv_b + ly * 768;
      const int lch = c * 128;
      const bf16_t* __restrict__ xbr = P->xbcr;
      float* __restrict__ xbo = P->xbc;
      {
        const int q = tid & 63;
        const int col = (q < 32) ? (256 + g * 128 + q * 4) : (512 + g * 128 + (q - 32) * 4);
        f32x4 w0 = *(const f32x4*)(cw + col), w1 = *(const f32x4*)(cw + 768 + col), w2 = *(const f32x4*)(cw + 2 * 768 + col);
        f32x4 w3 = *(const f32x4*)(cw + 3 * 768 + col), w4 = *(const f32x4*)(cw + 4 * 768 + col), bb = *(const f32x4*)(cb + col);
        const bf16_t* xcol = xbr + (size_t)b * L * 768 + col;
#pragma unroll 1
        for (int tb = 0; tb < 4; ++tb) {
          u32x2 xq[4][5];
#pragma unroll
          for (int k = 0; k < 4; ++k) {
            const int l = lch + (tid >> 6) + 8 * (4 * tb + k);
#pragma unroll
            for (int dd = 0; dd < 5; ++dd) {
              int ld = l + dd - 2; ld = ld < 0 ? 0 : (ld > L - 1 ? L - 1 : ld);
              xq[k][dd] = *(const u32x2*)(xcol + (size_t)ld * 768);
            }
          }
#pragma unroll
          for (int k = 0; k < 4; ++k) {
            const int t = (tid >> 6) + 8 * (4 * tb + k);
            const int l = lch + t;
            f32x4 a = bb + w2 * unpack4(xq[k][2]);
            a += w0 * (l >= 2 ? 1.f : 0.f) * unpack4(xq[k][0]);
            a += w1 * (l >= 1 ? 1.f : 0.f) * unpack4(xq[k][1]);
            a += w3 * (l + 1 < L ? 1.f : 0.f) * unpack4(xq[k][3]);
            a += w4 * (l + 2 < L ? 1.f : 0.f) * unpack4(xq[k][4]);
            f32x4 o = {siluf(a[0]), siluf(a[1]), siluf(a[2]), siluf(a[3])};
            *(f32x4*)(xbo + (row0 + t) * 768 + col) = o;
            u32x2 pk = {pack2(o[0], o[1]), pack2(o[2], o[3])};
            if (q < 32) {
              const int n0 = q * 4;
              *(u32x2*)(sB + t * SROW + n0 * 2) = pk;
              *(bf16_t*)(sBT + (n0 + 0) * SROW + t * 2) = (bf16_t)(pk[0] & 0xffffu);
              *(bf16_t*)(sBT + (n0 + 1) * SROW + t * 2) = (bf16_t)(pk[0] >> 16);
              *(bf16_t*)(sBT + (n0 + 2) * SROW + t * 2) = (bf16_t)(pk[1] & 0xffffu);
              *(bf16_t*)(sBT + (n0 + 3) * SROW + t * 2) = (bf16_t)(pk[1] >> 16);
            } else {
              *(u32x2*)(sC + t * SROW + (q - 32) * 8) = pk;
            }
          }
        }
      }
      {
        const int q = tid & 31;
        const int col = g * 128 + q * 4;
        f32x4 w0 = *(const f32x4*)(cw + col), w1 = *(const f32x4*)(cw + 768 + col), w2 = *(const f32x4*)(cw + 2 * 768 + col);
        f32x4 w3 = *(const f32x4*)(cw + 3 * 768 + col), w4 = *(const f32x4*)(cw + 4 * 768 + col), bb = *(const f32x4*)(cb + col);
        const bf16_t* xcol = xbr + (size_t)b * L * 768 + col;
#pragma unroll 1
        for (int tb = 0; tb < 2; ++tb) {
          u32x2 xq[4][5];
#pragma unroll
          for (int k = 0; k < 4; ++k) {
            const int l = lch + (tid >> 5) + 16 * (4 * tb + k);
#pragma unroll
            for (int dd = 0; dd < 5; ++dd) {
              int ld = l + dd - 2; ld = ld < 0 ? 0 : (ld > L - 1 ? L - 1 : ld);
              xq[k][dd] = *(const u32x2*)(xcol + (size_t)ld * 768);
            }
          }
#pragma unroll
          for (int k = 0; k < 4; ++k) {
            const int t = (tid >> 5) + 16 * (4 * tb + k);
            const int l = lch + t;
            f32x4 a = bb + w2 * unpack4(xq[k][2]);
            a += w0 * (l >= 2 ? 1.f : 0.f) * unpack4(xq[k][0]);
            a += w1 * (l >= 1 ? 1.f : 0.f) * unpack4(xq[k][1]);
            a += w3 * (l + 1 < L ? 1.f : 0.f) * unpack4(xq[k][3]);
            a += w4 * (l + 2 < L ? 1.f : 0.f) * unpack4(xq[k][4]);
            f32x4 o = {siluf(a[0]), siluf(a[1]), siluf(a[2]), siluf(a[3])};
            *(f32x4*)(xbo + (row0 + t) * 768 + col) = o;
          }
        }
      }
    }
    __syncthreads();
    f32x4 G[4][2];
#pragma unroll
    for (int m = 0; m < 4; ++m)
#pragma unroll
      for (int n = 0; n < 2; ++n) G[m][n] = f32x4{0.f, 0.f, 0.f, 0.f};
    const int gl0 = (wid >> 2) * 64, gs0 = (wid & 3) * 32;
    lds_mma<4, 2, 128>(sC, sB, gl0, gs0, G, fr, fq);
    __syncthreads();
    if (wid < 4) {
      const int h = g * 2 + (wid >> 1), dir = wid & 1;
      const float a = -expf(P->ssm_a_log[ly * 8 + dir * 4 + h]);
      float* sA_ = sAcs4 + wid * 264;
      ssd_cumsum(P->dtv, row0, dir * 4 + h, a, dir, lane, sA_, sA_ + 132);
      if (lane == 0) P->cdec[(((size_t)b * 64 + c) * 4 + h) * 2 + dir] = expf(sA_[128]);
    }
    __syncthreads();
#pragma unroll 1
    for (int hd = 0; hd < 4; ++hd) {
      const int h = g * 2 + (hd >> 1), dir = hd & 1;
      const size_t sidx = (((size_t)b * 64 + c) * 4 + h) * 2 + dir;
      const float* sAcs = sAcs4 + hd * 264;
      const float* sdt = sAcs + 132;
      const float tot = sAcs[128];
      {
        const float* xg = P->xbc + row0 * 768 + h * 64 + (tid & 63);
        float xl[16];
#pragma unroll
        for (int k = 0; k < 16; ++k) xl[k] = xg[(size_t)((tid >> 6) + 8 * k) * 768];
#pragma unroll
        for (int k = 0; k < 16; ++k) {
          const int t = (tid >> 6) + 8 * k, pp = tid & 63;
          const float xv = xl[k] * sdt[t];
          *(bf16_t*)(sB + pp * SROW + t * 2) = f2bf(xv);
          *(bf16_t*)(sB + 64 * SROW + pp * SROW + t * 2) = f2bf(xv * __expf(tot - sAcs[t]));
        }
      }
      {
        float asx[2];
#pragma unroll
        for (int n = 0; n < 2; ++n) asx[n] = sAcs[gs0 + n * 16 + fr];
#pragma unroll
        for (int m = 0; m < 4; ++m)
#pragma unroll
          for (int j = 0; j < 4; ++j) {
            const int l = gl0 + m * 16 + fq * 4 + j;
            const float al = sAcs[l];
#pragma unroll
            for (int n = 0; n < 2; ++n) {
              const int sx = gs0 + n * 16 + fr;
              const bool ok = dir ? (sx >= l) : (sx <= l);
              const float ev = __expf(fminf(al - asx[n], 0.f));
              const float v = ok ? G[m][n][j] * ev : 0.f;
              *(bf16_t*)(sC + l * SROW + sx * 2) = f2bf(v);
            }
          }
      }
      __syncthreads();
      {
        f32x4 Y[2][2];
#pragma unroll
        for (int m = 0; m < 2; ++m)
#pragma unroll
          for (int n = 0; n < 2; ++n) Y[m][n] = f32x4{0.f, 0.f, 0.f, 0.f};
        const int yl0 = (wid >> 1) * 32, yp0 = (wid & 1) * 32;
        lds_mma<2, 2, 128>(sC, sB, yl0, yp0, Y, fr, fq);
        float* yo = dir ? P->yb : P->yf;
#pragma unroll
        for (int m = 0; m < 2; ++m)
#pragma unroll
          for (int n = 0; n < 2; ++n)
#pragma unroll
            for (int j = 0; j < 4; ++j) {
              int t = yl0 + m * 16 + fq * 4 + j, pp = yp0 + n * 16 + fr;
              yo[(row0 + t) * 256 + h * 64 + pp] = Y[m][n][j];
            }
      }
      {
        f32x4 S[2][2];
#pragma unroll
        for (int m = 0; m < 2; ++m)
#pragma unroll
          for (int n = 0; n < 2; ++n) S[m][n] = f32x4{0.f, 0.f, 0.f, 0.f};
        const int sp0 = (wid >> 2) * 32, sn0 = (wid & 3) * 32;
        lds_mma<2, 2, 128>(sB + 64 * SROW, sBT, sp0, sn0, S, fr, fq);
        float* so = P->states + sidx * 8192;
#pragma unroll
        for (int m = 0; m < 2; ++m)
#pragma unroll
          for (int n = 0; n < 2; ++n)
#pragma unroll
            for (int j = 0; j < 4; ++j) {
              int pp = sp0 + m * 16 + fq * 4 + j, nn = sn0 + n * 16 + fr;
              so[pp * 128 + nn] = S[m][n][j];
            }
      }
      __syncthreads();
    }
  }
}

__device__ __forceinline__ void phase_ssd_scan(KP P) {
  LAUNDER_IDS
  for (int e = BIDX * NTHREADS + TIDX; e < 131072; e += GDIM * NTHREADS) {
    const int pn = e & 8191, dir = (e >> 13) & 1, h = (e >> 14) & 3, b = e >> 16;
    float st = 0.f;
#pragma unroll
    for (int half = 0; half < 2; ++half) {
      float sv[32], dv[32];
#pragma unroll
      for (int k = 0; k < 32; ++k) {
        const int kk = half * 32 + k;
        const int c = dir ? (63 - kk) : kk;
        const size_t sidx = (((size_t)b * 64 + c) * 4 + h) * 2 + dir;
        sv[k] = P->states[sidx * 8192 + pn];
        dv[k] = P->cdec[sidx];
      }
#pragma unroll
      for (int k = 0; k < 32; ++k) {
        const int kk = half * 32 + k;
        const int c = dir ? (63 - kk) : kk;
        const size_t sidx = (((size_t)b * 64 + c) * 4 + h) * 2 + dir;
        P->prevb[sidx * 8192 + pn] = f2bf(st);
        st = st * dv[k] + sv[k];
      }
    }
  }
}

__device__ __forceinline__ void phase_ssd3(KP P, int ly, char* smem) {
  LAUNDER_IDS
  const int tid = TIDX, lane = tid & 63, wid = tid >> 6, fr = lane & 15, fq = lane >> 4;
  char* sC = smem;
  char* sP = smem + SMAT;
  float* sAcs = (float*)(smem + 2 * SMAT);
  float* sdt = sAcs + 132;
  for (int it = BIDX; it < 256; it += GDIM) {
    const int g = it & 1, c = (it >> 1) & 63, b = it >> 7;
    const size_t row0 = (size_t)b * L + c * 128;
    __syncthreads();
    {
      const float* cg = P->xbc + row0 * 768 + 512 + g * 128 + (tid & 63) * 2;
      float2 cl[16];
#pragma unroll
      for (int k = 0; k < 16; ++k) cl[k] = *(const float2*)(cg + (size_t)((tid >> 6) + 8 * k) * 768);
#pragma unroll
      for (int k = 0; k < 16; ++k) *(uint32_t*)(sC + ((tid >> 6) + 8 * k) * SROW + (tid & 63) * 4) = pack2(cl[k].x, cl[k].y);
    }
#pragma unroll 1
    for (int hd = 0; hd < 4; ++hd) {
      const int h = g * 2 + (hd >> 1), dir = hd & 1;
      const float a = -expf(P->ssm_a_log[ly * 8 + dir * 4 + h]);
      const size_t sidx = (((size_t)b * 64 + c) * 4 + h) * 2 + dir;
      if (wid == 0) ssd_cumsum(P->dtv, row0, dir * 4 + h, a, dir, lane, sAcs, sdt);
      const u32x4* pg = (const u32x4*)(P->prevb + sidx * 8192);
      for (int i = tid; i < 1024; i += NTHREADS) {
        int pp = i >> 4, ch = i & 15;
        *(u32x4*)(sP + pp * SROW + ch * 16) = pg[i];
      }
      __syncthreads();
      f32x4 Y[2][2];
#pragma unroll
      for (int m = 0; m < 2; ++m)
#pragma unroll
        for (int n = 0; n < 2; ++n) Y[m][n] = f32x4{0.f, 0.f, 0.f, 0.f};
      const int yl0 = (wid >> 1) * 32, yp0 = (wid & 1) * 32;
      lds_mma<2, 2, 128>(sC, sP, yl0, yp0, Y, fr, fq);
      float* yo = (dir ? P->yb : P->yf) + row0 * 256 + h * 64 + yp0 + fr;
      float yv[2][4][2];
#pragma unroll
      for (int m = 0; m < 2; ++m)
#pragma unroll
        for (int j = 0; j < 4; ++j)
#pragma unroll
          for (int n = 0; n < 2; ++n) yv[m][j][n] = yo[(size_t)(yl0 + m * 16 + fq * 4 + j) * 256 + n * 16];
#pragma unroll
      for (int m = 0; m < 2; ++m)
#pragma unroll
        for (int j = 0; j < 4; ++j) {
          const int t = yl0 + m * 16 + fq * 4 + j;
          const float sc = __expf(sAcs[t]);
#pragma unroll
          for (int n = 0; n < 2; ++n) yo[(size_t)t * 256 + n * 16] = yv[m][j][n] + sc * Y[m][n][j];
        }
      __syncthreads();
    }
  }
}

__device__ __forceinline__ void phase_prep3b(KP P, float* sm) {
  LAUNDER_IDS
  const float qs = 0.14724445f;
  for (int t = BIDX; t < T / 64; t += GDIM) {
    const int row0 = t * 64;
    const int b = row0 / L, l0 = row0 % L;
    for (int i = TIDX; i < 64 * 8 * 48; i += NTHREADS) {
      int jj = i % 48, h = (i / 48) & 7, r = i / (48 * 8);
      int row = row0 + r;
      size_t bh = (size_t)(b * 8 + h);
      const float* qr = P->qraw + (size_t)row * 768 + h * 96;
      bf16_t* Q = P->Qb + (bh * L + l0 + r) * 96;
      if (jj < 32) {
        *(uint32_t*)(Q + 2 * jj) = pack2(qr[2 * jj] * qs, qr[2 * jj + 1] * qs);
      } else {
        int jf = jj - 32;
        float cs, sn;
        rope_cs(P->pos[row], jf, cs, sn);
        float q1 = qr[64 + jf], q2 = qr[80 + jf];
        Q[64 + jf] = f2bf((q1 * cs - q2 * sn) * qs);
        Q[80 + jf] = f2bf((q2 * cs + q1 * sn) * qs);
      }
    }
    for (int i = TIDX; i < 64 * 8 * 32; i += NTHREADS) {
      int jj = i & 31, h = (i >> 5) & 7, r = i >> 8;
      int row = row0 + r;
      size_t bh = (size_t)(b * 8 + h);
      const float* kvr = P->kvraw + (size_t)row * 1024 + h * 128;
      *(uint32_t*)(P->Kn + (bh * L + l0 + r) * 64 + 2 * jj) = pack2(kvr[2 * jj], kvr[2 * jj + 1]);
    }
    for (int i = TIDX; i < 64 * 16; i += NTHREADS) {
      int jf = i & 15, r = i >> 4;
      int row = row0 + r;
      const float* kr = P->proj + (size_t)row * NIN + C_KR;
      float cs, sn;
      rope_cs(P->pos[row], jf, cs, sn);
      float k1 = kr[jf], k2 = kr[16 + jf];
      P->Kr[(size_t)row * 32 + jf] = f2bf(k1 * cs - k2 * sn);
      P->Kr[(size_t)row * 32 + 16 + jf] = f2bf(k2 * cs + k1 * sn);
    }
    for (int h = 0; h < 8; ++h) {
      size_t bh = (size_t)(b * 8 + h);
      __syncthreads();
      for (int i = TIDX; i < 64 * 64; i += NTHREADS) {
        int r = i >> 6, c = i & 63;
        sm[r * 65 + c] = P->kvraw[(size_t)(row0 + r) * 1024 + h * 128 + 64 + c];
      }
      __syncthreads();
      for (int i = TIDX; i < 64 * 32; i += NTHREADS) {
        int dv = i >> 5, lp = i & 31;
        const int kp = 2 * lp, kperm = (kp & ~12) | ((kp & 4) << 1) | ((kp & 8) >> 1);
        *(uint32_t*)(P->Vt + (bh * 64 + dv) * L + l0 + kperm) = pack2(sm[(2 * lp) * 65 + dv], sm[(2 * lp + 1) * 65 + dv]);
      }
    }
  }
}

constexpr int AK_ROW = 208, AV_ROW = 264;
constexpr int AK_BYTES = 128 * AK_ROW, AV_BYTES = 64 * AV_ROW, ABUF = AK_BYTES + AV_BYTES;
#define MFMA32(a, b, c) __builtin_amdgcn_mfma_f32_32x32x16_bf16((a), (b), (c), 0, 0, 0)

__device__ __forceinline__ void attn_rowmax_init(const f32x16& sc, float& m) {
  float m0 = fmaxf(fmaxf(sc[0], sc[1]), fmaxf(sc[2], sc[3])), m1 = fmaxf(fmaxf(sc[4], sc[5]), fmaxf(sc[6], sc[7]));
  float m2 = fmaxf(fmaxf(sc[8], sc[9]), fmaxf(sc[10], sc[11])), m3 = fmaxf(fmaxf(sc[12], sc[13]), fmaxf(sc[14], sc[15]));
  float mx = fmaxf(fmaxf(m0, m1), fmaxf(m2, m3));
  m = fmaxf(mx, __shfl_xor(mx, 32));
}

__device__ __forceinline__ void attn_softmax32(f32x16& sc, float& m, float& lsum, f32x16& o0, f32x16& o1, bf16x8 (&pf)[2]) {
  f32v2_t d[8];
  const f32v2_t mm = {m, m};
#pragma unroll
  for (int i = 0; i < 8; ++i) { const f32v2_t s2 = {sc[2 * i], sc[2 * i + 1]}; d[i] = s2 - mm; }
  const float t0 = fmaxf(fmaxf(d[0][0], d[0][1]), d[1][0]);
  const float t1 = fmaxf(fmaxf(d[1][1], d[2][0]), d[2][1]);
  const float t2 = fmaxf(fmaxf(d[3][0], d[3][1]), d[4][0]);
  const float t3 = fmaxf(fmaxf(d[4][1], d[5][0]), d[5][1]);
  const float t4 = fmaxf(fmaxf(d[6][0], d[6][1]), d[7][0]);
  float mx = fmaxf(fmaxf(fmaxf(t0, t1), t2), fmaxf(fmaxf(t3, t4), d[7][1]));
  if (__any(mx > 8.f)) {
    mx = fmaxf(mx, __shfl_xor(mx, 32));
    const float delta = fmaxf(mx, 0.f);
    const float alpha = __builtin_amdgcn_exp2f(-delta);
    m += delta;
    lsum *= alpha;
#pragma unroll
    for (int i = 0; i < 16; ++i) { o0[i] *= alpha; o1[i] *= alpha; }
    const f32v2_t dd = {delta, delta};
#pragma unroll
    for (int i = 0; i < 8; ++i) d[i] -= dd;
  }
  f32v2_t ps0 = {0.f, 0.f}, ps1 = {0.f, 0.f};
#pragma unroll
  for (int i = 0; i < 8; i += 2) {
    d[i][0] = __builtin_amdgcn_exp2f(d[i][0]); d[i][1] = __builtin_amdgcn_exp2f(d[i][1]); ps0 += d[i];
    d[i + 1][0] = __builtin_amdgcn_exp2f(d[i + 1][0]); d[i + 1][1] = __builtin_amdgcn_exp2f(d[i + 1][1]); ps1 += d[i + 1];
  }
  ps0 += ps1;
  lsum += ps0[0] + ps0[1];
  u32x4 t;
  t[0] = pack2(d[0][0], d[0][1]); t[1] = pack2(d[1][0], d[1][1]); t[2] = pack2(d[2][0], d[2][1]); t[3] = pack2(d[3][0], d[3][1]);
  pf[0] = __builtin_bit_cast(bf16x8, t);
  t[0] = pack2(d[4][0], d[4][1]); t[1] = pack2(d[5][0], d[5][1]); t[2] = pack2(d[6][0], d[6][1]); t[3] = pack2(d[7][0], d[7][1]);
  pf[1] = __builtin_bit_cast(bf16x8, t);
}

constexpr int AS_KR = 16384, AS_VT = 24576, ASLOT = 40960;
#define ASB() __builtin_amdgcn_sched_barrier(0)
template <bool PV, bool VRELOAD>
__device__ __forceinline__ void attn_hs(f32x16& oX0, f32x16& oX1, const bf16x8 (&pX)[2], f32x16& sX, const bf16x8 (&qX)[6],
                                        const f32x16& sY, float& mY, float& lY, f32x16& oY0, f32x16& oY1, bf16x8 (&pY)[2],
                                        bf16x8 (&vf)[4], const char* kslot, const int kn_l, const int kr_l,
                                        const char* vslot, const int v_l0, const int v_l1, const float wv) {
  bf16x8 kf[6];
  f32v2_t d[8];
  const f32v2_t mm = {mY, mY};
  if (PV) oX0 = MFMA32(vf[0], pX[0], oX0);
#pragma unroll
  for (int i = 0; i < 4; ++i) { const f32v2_t s2 = {sY[2 * i], sY[2 * i + 1]}; d[i] = s2 - mm; }
  ASB();
  if (PV) oX1 = MFMA32(vf[1], pX[0], oX1);
  kf[0] = *(const bf16x8*)(kslot + kn_l); kf[1] = *(const bf16x8*)(kslot + (kn_l ^ 32));
#pragma unroll
  for (int i = 4; i < 8; ++i) { const f32v2_t s2 = {sY[2 * i], sY[2 * i + 1]}; d[i] = s2 - mm; }
  ASB();
  if (PV) oX0 = MFMA32(vf[2], pX[1], oX0);
  const float t0 = fmaxf(fmaxf(d[0][0], d[0][1]), d[1][0]);
  const float t1 = fmaxf(fmaxf(d[1][1], d[2][0]), d[2][1]);
  const float t2 = fmaxf(fmaxf(d[3][0], d[3][1]), d[4][0]);
  const float t3 = fmaxf(fmaxf(d[4][1], d[5][0]), d[5][1]);
  const float t4 = fmaxf(fmaxf(d[6][0], d[6][1]), d[7][0]);
  ASB();
  if (PV) oX1 = MFMA32(vf[3], pX[1], oX1);
  kf[2] = *(const bf16x8*)(kslot + (kn_l ^ 64)); kf[3] = *(const bf16x8*)(kslot + (kn_l ^ 96));
  float mx = fmaxf(fmaxf(fmaxf(t0, t1), t2), fmaxf(fmaxf(t3, t4), d[7][1]));
  ASB();
  if (__any(mx > 8.f)) {
    mx = fmaxf(mx, __shfl_xor(mx, 32));
    const float delta = fmaxf(mx, 0.f);
    const float alpha = __builtin_amdgcn_exp2f(-delta);
    mY += delta;
    lY *= alpha;
#pragma unroll
    for (int i = 0; i < 16; ++i) { oY0[i] *= alpha; oY1[i] *= alpha; }
    const f32v2_t dd = {delta, delta};
#pragma unroll
    for (int i = 0; i < 8; ++i) d[i] -= dd;
  }
  f32x16 acc;
#pragma unroll
  for (int i = 0; i < 16; ++i) acc[i] = 0.f;
  acc = MFMA32(kf[0], qX[0], acc);
  kf[4] = *(const bf16x8*)(kslot + kr_l); kf[5] = *(const bf16x8*)(kslot + (kr_l ^ 32));
  d[0][0] = __builtin_amdgcn_exp2f(d[0][0]); d[0][1] = __builtin_amdgcn_exp2f(d[0][1]);
  d[1][0] = __builtin_amdgcn_exp2f(d[1][0]); d[1][1] = __builtin_amdgcn_exp2f(d[1][1]);
  ASB();
  acc = MFMA32(kf[1], qX[1], acc);
  d[2][0] = __builtin_amdgcn_exp2f(d[2][0]); d[2][1] = __builtin_amdgcn_exp2f(d[2][1]);
  d[3][0] = __builtin_amdgcn_exp2f(d[3][0]); d[3][1] = __builtin_amdgcn_exp2f(d[3][1]);
  f32v2_t ps0 = d[0] + d[2], ps1 = d[1] + d[3];
  ASB();
  acc = MFMA32(kf[2], qX[2], acc);
  d[4][0] = __builtin_amdgcn_exp2f(d[4][0]); d[4][1] = __builtin_amdgcn_exp2f(d[4][1]);
  d[5][0] = __builtin_amdgcn_exp2f(d[5][0]); d[5][1] = __builtin_amdgcn_exp2f(d[5][1]);
  u32x4 t;
  t[0] = pack2(d[0][0], d[0][1]); t[1] = pack2(d[1][0], d[1][1]); t[2] = pack2(d[2][0], d[2][1]); t[3] = pack2(d[3][0], d[3][1]);
  pY[0] = __builtin_bit_cast(bf16x8, t);
  ASB();
  acc = MFMA32(kf[3], qX[3], acc);
  if (VRELOAD) {
    vf[0] = *(const bf16x8*)(vslot + v_l0); vf[1] = *(const bf16x8*)(vslot + v_l0 + 8192);
    vf[2] = *(const bf16x8*)(vslot + v_l1); vf[3] = *(const bf16x8*)(vslot + v_l1 + 8192);
  }
  d[6][0] = __builtin_amdgcn_exp2f(d[6][0]); d[6][1] = __builtin_amdgcn_exp2f(d[6][1]);
  d[7][0] = __builtin_amdgcn_exp2f(d[7][0]); d[7][1] = __builtin_amdgcn_exp2f(d[7][1]);
  ps0 += d[4]; ps1 += d[5];
  ASB();
  acc = MFMA32(kf[4], qX[4], acc);
  ps0 += d[6]; ps1 += d[7];
  t[0] = pack2(d[4][0], d[4][1]); t[1] = pack2(d[5][0], d[5][1]); t[2] = pack2(d[6][0], d[6][1]); t[3] = pack2(d[7][0], d[7][1]);
  pY[1] = __builtin_bit_cast(bf16x8, t);
  ASB();
  acc = MFMA32(kf[5], qX[5], acc);
  ps0 += ps1;
  lY = fmaf(ps0[0] + ps0[1], wv, lY);
  ASB();
  sX = acc;
}

__device__ __forceinline__ void phase_attn_mfma(KP P, char* smem) {
  LAUNDER_IDS
  const int tid = TIDX, lane = tid & 63;
  const int wid = __builtin_amdgcn_readfirstlane(tid >> 6);
  const int q32 = lane & 31, hh = lane >> 5;
  const bf16_t* Qb = P->Qb;
  const bf16_t* Kn = P->Kn;
  const bf16_t* Kr = P->Kr;
  const bf16_t* Vt = P->Vt;
  bf16_t* oattn = P->oattn;
  constexpr int NT = L / 128;
  XLAS char* lds = (XLAS char*)smem;
  unsigned gkn[2], gvt[2], gkr;
#pragma unroll
  for (int t = 0; t < 2; ++t) {
    const int rk = (2 * wid + t) * 8 + (lane >> 3), ck = (lane & 7) ^ ((rk >> 1) & 7);
    gkn[t] = (unsigned)(rk * 128 + ck * 16);
    const int rv = (2 * wid + t) * 4 + (lane >> 4), cv = (lane & 15) ^ (rv & 15);
    gvt[t] = (unsigned)(rv * (L * 2) + cv * 16);
  }
  { const int rr = wid * 16 + (lane >> 2), cr = (lane & 3) ^ ((rr >> 2) & 3); gkr = (unsigned)(rr * 64 + cr * 16); }
  const int kn_l = q32 * 128 + ((16 * hh) ^ (16 * ((q32 >> 1) & 7)));
  const int kr_l = AS_KR + q32 * 64 + ((16 * hh) ^ (16 * ((q32 >> 2) & 3)));
  const int v_l = AS_VT + q32 * 256 + ((16 * hh) ^ (16 * (q32 & 15)));
  for (int item = BIDX; item < 16 * 16; item += GDIM) {
    const int xg = item & 7, xj = item >> 3;
    const int bh = (xg * 2 + (xj >> 4)) & 15, qb = xj & 15, b = bh >> 3, h = bh & 7;
    const int qrow = qb * 512 + wid * 64 + q32;
    bf16x8 qfA[6], qfB[6];
    {
      const bf16_t* qp = Qb + ((size_t)bh * L + qrow) * 96 + hh * 8;
#pragma unroll
      for (int s = 0; s < 6; ++s) { qfA[s] = *(const bf16x8*)(qp + s * 16); qfB[s] = *(const bf16x8*)(qp + 32 * 96 + s * 16); }
    }
    f32x16 oA0, oA1, oB0, oB1;
#pragma unroll
    for (int i = 0; i < 16; ++i) { oA0[i] = 0.f; oA1[i] = 0.f; oB0[i] = 0.f; oB1[i] = 0.f; }
    float mA = -1e30f, lA = 0.f, mB = -1e30f, lB = 0.f;
    const char* kn_t = (const char*)(Kn + (size_t)bh * L * 64);
    const char* kr_t = (const char*)(Kr + (size_t)b * L * 32);
    const char* vt_t = (const char*)(Vt + (size_t)bh * 64 * L);
#define ATT_DMA(kt_, slot_) do { const size_t _kt = (size_t)(kt_); const unsigned _so = (unsigned)(slot_) + (unsigned)wid * 2048u; \
      __builtin_amdgcn_global_load_lds((const unsigned*)(kn_t + _kt * (128 * 128) + gkn[0]), (XLAS unsigned*)(lds + _so), 16, 0, 0); \
      __builtin_amdgcn_global_load_lds((const unsigned*)(kn_t + _kt * (128 * 128) + gkn[1]), (XLAS unsigned*)(lds + _so + 1024), 16, 0, 0); \
      __builtin_amdgcn_global_load_lds((const unsigned*)(kr_t + _kt * (128 * 64) + gkr), (XLAS unsigned*)(lds + (unsigned)(slot_) + AS_KR + (unsigned)wid * 1024u), 16, 0, 0); \
      __builtin_amdgcn_global_load_lds((const unsigned*)(vt_t + _kt * 256 + gvt[0]), (XLAS unsigned*)(lds + _so + AS_VT), 16, 0, 0); \
      __builtin_amdgcn_global_load_lds((const unsigned*)(vt_t + _kt * 256 + gvt[1]), (XLAS unsigned*)(lds + _so + AS_VT + 1024), 16, 0, 0); } while (0)
    __syncthreads();
    ATT_DMA(0, 0);
    asm volatile("s_waitcnt vmcnt(0)" ::: "memory");
    __syncthreads();
    f32x16 sA, sB;
    bf16x8 pA[2], pB[2], vf[4];
    {
      bf16x8 kf[6];
#pragma unroll
      for (int s = 0; s < 4; ++s) kf[s] = *(const bf16x8*)(smem + (kn_l ^ (32 * s)));
      kf[4] = *(const bf16x8*)(smem + kr_l); kf[5] = *(const bf16x8*)(smem + (kr_l ^ 32));
#pragma unroll
      for (int i = 0; i < 16; ++i) { sA[i] = 0.f; sB[i] = 0.f; }
#pragma unroll
      for (int s = 0; s < 6; ++s) { sA = MFMA32(kf[s], qfA[s], sA); sB = MFMA32(kf[s], qfB[s], sB); }
      attn_rowmax_init(sA, mA); attn_rowmax_init(sB, mB);
      attn_softmax32(sA, mA, lA, oA0, oA1, pA);
      vf[0] = *(const bf16x8*)(smem + v_l); vf[1] = *(const bf16x8*)(smem + v_l + 8192);
      vf[2] = *(const bf16x8*)(smem + (v_l ^ 32)); vf[3] = *(const bf16x8*)(smem + (v_l ^ 32) + 8192);
    }
    if (wid >= 4) __builtin_amdgcn_s_setprio(1);
    int scur = 0, snxt = ASLOT, snn = 2 * ASLOT;
    for (int kt = 0; kt < NT; ++kt) {
      const char* bc = smem + scur;
      const char* bn = smem + snxt;
      const int kn_ = (kt + 1 < NT) ? (kt + 1) : kt;
      ATT_DMA(kn_, snxt);
#pragma unroll
      for (int j = 0; j < 3; ++j) {
        const char* ks = bc + (32 * (j + 1)) * 128 - 0;
        attn_hs<true, false>(oA0, oA1, pA, sA, qfA, sB, mB, lB, oB0, oB1, pB, vf, bc, kn_l + 4096 * (j + 1), kr_l + 2048 * (j + 1),
                             bc, v_l ^ (64 * (j + 1)), v_l ^ (64 * (j + 1) + 32), 1.f);
        attn_hs<true, true>(oB0, oB1, pB, sB, qfB, sA, mA, lA, oA0, oA1, pA, vf, bc, kn_l + 4096 * (j + 1), kr_l + 2048 * (j + 1),
                            bc, v_l ^ (64 * (j + 1)), v_l ^ (64 * (j + 1) + 32), 1.f);
        (void)ks;
      }
      asm volatile("s_waitcnt vmcnt(0)" ::: "memory");
      __syncthreads();
      {
        const float wv = (kt + 1 < NT) ? 1.f : 0.f;
        attn_hs<true, false>(oA0, oA1, pA, sA, qfA, sB, mB, lB, oB0, oB1, pB, vf, bn, kn_l, kr_l, bn, v_l, v_l ^ 32, 1.f);
        attn_hs<true, true>(oB0, oB1, pB, sB, qfB, sA, mA, lA, oA0, oA1, pA, vf, bn, kn_l, kr_l, bn, v_l, v_l ^ 32, wv);
      }
      const int t_ = scur; scur = snxt; snxt = snn; snn = t_;
    }
#undef ATT_DMA
    __builtin_amdgcn_s_setprio(0);
    {
      const float inv = 1.f / (lA + __shfl_xor(lA, 32));
      bf16_t* op = oattn + ((size_t)b * L + qrow) * 512 + h * 64 + 4 * hh;
#pragma unroll
      for (int g = 0; g < 4; ++g) {
        u32x2 w0 = {pack2(oA0[4 * g] * inv, oA0[4 * g + 1] * inv), pack2(oA0[4 * g + 2] * inv, oA0[4 * g + 3] * inv)};
        u32x2 w1 = {pack2(oA1[4 * g] * inv, oA1[4 * g + 1] * inv), pack2(oA1[4 * g + 2] * inv, oA1[4 * g + 3] * inv)};
        *(u32x2*)(op + 8 * g) = w0;
        *(u32x2*)(op + 32 + 8 * g) = w1;
      }
    }
    {
      const float inv = 1.f / (lB + __shfl_xor(lB, 32));
      bf16_t* op = oattn + ((size_t)b * L + qrow + 32) * 512 + h * 64 + 4 * hh;
#pragma unroll
      for (int g = 0; g < 4; ++g) {
        u32x2 w0 = {pack2(oB0[4 * g] * inv, oB0[4 * g + 1] * inv), pack2(oB0[4 * g + 2] * inv, oB0[4 * g + 3] * inv)};
        u32x2 w1 = {pack2(oB1[4 * g] * inv, oB1[4 * g + 1] * inv), pack2(oB1[4 * g + 2] * inv, oB1[4 * g + 3] * inv)};
        *(u32x2*)(op + 8 * g) = w0;
        *(u32x2*)(op + 32 + 8 * g) = w1;
      }
    }
  }
}

__device__ __forceinline__ void phase_prep4(KP P, int ly, float* sm) {
  LAUNDER_IDS
  const int tid = TIDX, lane = tid & 63, wid = tid >> 6;
  const float* gm = P->mla_out_norm + ly * 512;
  const float* gh = P->hy_out_norm + ly * 256;
  const float* gs = P->ssm_norm + ly * 256;
  const float* dsk = P->ssm_d + ly * 4;
  for (int t = BIDX; t < T / 32; t += GDIM) {
    int row0 = t * 32;
    int b = row0 / L, l0 = row0 % L;
    __syncthreads();
    for (int i = tid; i < 256 * 32; i += NTHREADS) {
      int c = i >> 5, ll = i & 31;
      sm[c * 33 + ll] = P->ohyT[((size_t)b * 256 + c) * L + l0 + ll];
    }
    __syncthreads();
#pragma unroll
    for (int rk = 0; rk < 4; ++rk) {
      const int rr = wid + 8 * rk;
      int row = row0 + rr;
      bf16_t* ao = P->A1 + (size_t)row * D;
      {
        u32x4 raw = *(const u32x4*)(P->oattn + (size_t)row * 512 + lane * 8);
        f32x4 va = unpack4(u32x2{raw[0], raw[1]}), vb = unpack4(u32x2{raw[2], raw[3]});
        float ssm = va[0] * va[0] + va[1] * va[1] + va[2] * va[2] + va[3] * va[3] + vb[0] * vb[0] + vb[1] * vb[1] + vb[2] * vb[2] + vb[3] * vb[3];
        ssm = wave_sum(ssm);
        const float rsm = rsqrtf(ssm * (1.f / 512.f) + EPS);
        f32x4 ga = *(const f32x4*)(gm + lane * 8), gb = *(const f32x4*)(gm + lane * 8 + 4);
        u32x4 o = {pack2(va[0] * rsm * ga[0], va[1] * rsm * ga[1]), pack2(va[2] * rsm * ga[2], va[3] * rsm * ga[3]),
                   pack2(vb[0] * rsm * gb[0], vb[1] * rsm * gb[1]), pack2(vb[2] * rsm * gb[2], vb[3] * rsm * gb[3])};
        *(u32x4*)(ao + lane * 8) = o;
      }
      float hv[4];
      float ss = 0.f;
#pragma unroll
      for (int i = 0; i < 4; ++i) { hv[i] = sm[(lane + 64 * i) * 33 + rr]; ss += hv[i] * hv[i]; }
      ss = wave_sum(ss);
      float rs = rsqrtf(ss * (1.f / 256.f) + EPS);
#pragma unroll
      for (int i = 0; i < 4; ++i) ao[512 + lane + 64 * i] = f2bf(hv[i] * rs * gh[lane + 64 * i]);
      {
        const int c = lane * 4;
        f32x4 yfv = *(const f32x4*)(P->yf + (size_t)row * 256 + c), ybv = *(const f32x4*)(P->yb + (size_t)row * 256 + c);
        f32x4 xv = *(const f32x4*)(P->xbc + (size_t)row * 768 + c);
        f32x4 zv = unpack4(*(const u32x2*)(P->zbuf + (size_t)row * 256 + c));
        const float dh = dsk[lane >> 4];
        f32x4 y = yfv + ybv + xv * dh;
        y[0] *= siluf(zv[0]); y[1] *= siluf(zv[1]); y[2] *= siluf(zv[2]); y[3] *= siluf(zv[3]);
        float sg = y[0] * y[0] + y[1] * y[1] + y[2] * y[2] + y[3] * y[3];
        sg += __shfl_xor(sg, 1); sg += __shfl_xor(sg, 2); sg += __shfl_xor(sg, 4); sg += __shfl_xor(sg, 8); sg += __shfl_xor(sg, 16);
        const float rg = rsqrtf(sg * (1.f / 128.f) + EPS);
        f32x4 g4 = *(const f32x4*)(gs + c);
        u32x2 o = {pack2(y[0] * rg * g4[0], y[1] * rg * g4[1]), pack2(y[2] * rg * g4[2], y[3] * rg * g4[3])};
        *(u32x2*)(ao + 768 + c) = o;
      }
    }
  }
}

__device__ __forceinline__ void phase_prep5(KP P, int ly, float* sm) {
  LAUNDER_IDS
  const int lane = TIDX & 63;
  const int gw = BIDX * 8 + (TIDX >> 6), nw = GDIM * 8;
  const float* g = P->norm_ffn + ly * D;
  const float* R = P->router + (size_t)ly * D * NE;
  __syncthreads();
  for (int i = TIDX; i < D * NE; i += NTHREADS) { int c = i >> 4, e = i & 15; sm[e * D + c] = R[i]; }
  __syncthreads();
  f32x4 nxv[4];
  f32x4 nxp;
  {
    const int r0 = (gw < T) ? gw : 0;
#pragma unroll
    for (int i = 0; i < 4; ++i) nxv[i] = *(const f32x4*)(P->xcur + (size_t)r0 * D + i * 256 + lane * 4);
    nxp = *(const f32x4*)(P->p + ((size_t)ly * T + r0) * 256 + lane * 4);
  }
  for (int row = gw; row < T; row += nw) {
    f32x4 v[4];
    f32x4 p4 = nxp;
    float ss = 0.f;
#pragma unroll
    for (int i = 0; i < 4; ++i) {
      v[i] = nxv[i];
      ss += v[i][0] * v[i][0] + v[i][1] * v[i][1] + v[i][2] * v[i][2] + v[i][3] * v[i][3];
    }
    {
      const int nr = (row + nw < T) ? (row + nw) : row;
#pragma unroll
      for (int i = 0; i < 4; ++i) nxv[i] = *(const f32x4*)(P->xcur + (size_t)nr * D + i * 256 + lane * 4);
      nxp = *(const f32x4*)(P->p + ((size_t)ly * T + nr) * 256 + lane * 4);
    }
    ss = wave_sum(ss);
    float rs = rsqrtf(ss * (1.f / D) + EPS);
    bf16_t* ao = P->A1 + (size_t)row * D;
#pragma unroll
    for (int i = 0; i < 4; ++i) {
      int c = i * 256 + lane * 4;
      f32x4 g4 = *(const f32x4*)(g + c);
      v[i] = v[i] * g4 * rs;
      u32x2 o = {pack2(v[i][0], v[i][1]), pack2(v[i][2], v[i][3])};
      *(u32x2*)(ao + c) = o;
    }
    float lg[16];
    int smoff = lane * 4;
    asm volatile("" : "+v"(smoff));
    const float* smr = sm + smoff;
#pragma unroll
    for (int e = 0; e < 16; ++e) {
      float a = 0.f;
#pragma unroll
      for (int i = 0; i < 4; ++i) {
        f32x4 r4 = *(const f32x4*)(smr + e * D + i * 256);
        a += v[i][0] * r4[0] + v[i][1] * r4[1] + v[i][2] * r4[2] + v[i][3] * r4[3];
      }
      lg[e] = a;
    }
    float r8[8], r4[4], r2[2], r1;
    {
      const bool up = (lane & 32) != 0;
#pragma unroll
      for (int k = 0; k < 8; ++k) { float snd = up ? lg[k] : lg[8 + k]; float keep = up ? lg[8 + k] : lg[k]; r8[k] = keep + __shfl_xor(snd, 32); }
    }
    {
      const bool up = (lane & 16) != 0;
#pragma unroll
      for (int k = 0; k < 4; ++k) { float snd = up ? r8[k] : r8[4 + k]; float keep = up ? r8[4 + k] : r8[k]; r4[k] = keep + __shfl_xor(snd, 16); }
    }
    {
      const bool up = (lane & 8) != 0;
#pragma unroll
      for (int k = 0; k < 2; ++k) { float snd = up ? r4[k] : r4[2 + k]; float keep = up ? r4[2 + k] : r4[k]; r2[k] = keep + __shfl_xor(snd, 8); }
    }
    {
      const bool up = (lane & 4) != 0;
      float snd = up ? r2[0] : r2[1]; float keep = up ? r2[1] : r2[0];
      r1 = keep + __shfl_xor(snd, 4);
    }
    r1 += __shfl_xor(r1, 2);
    r1 += __shfl_xor(r1, 1);
    float mx = r1;
    mx = fmaxf(mx, __shfl_xor(mx, 4)); mx = fmaxf(mx, __shfl_xor(mx, 8)); mx = fmaxf(mx, __shfl_xor(mx, 16)); mx = fmaxf(mx, __shfl_xor(mx, 32));
    const float ex = expf(r1 - mx);
    float se = ex;
    se += __shfl_xor(se, 4); se += __shfl_xor(se, 8); se += __shfl_xor(se, 16); se += __shfl_xor(se, 32);
    const float mine = ex / se;
    int b = row / L, l = row % L;
    if ((lane & 3) == 0) P->affT[((size_t)b * NE + ((lane >> 2) & 15)) * L + l] = mine;
    u32x2 o = {pack2(p4[0], p4[1]), pack2(p4[2], p4[3])};
    *(u32x2*)(P->Ap + (size_t)row * 256 + lane * 4) = o;
  }
}

__device__ __forceinline__ void phase_topk(KP P, char* smem) {
  LAUNDER_IDS
  uint32_t* keys = (uint32_t*)smem;
  int* hist = (int*)(smem + 32768);
  int* misc = hist + 256;
  const int tid = TIDX, lane = tid & 63, wid = tid >> 6;
  for (int it = BIDX; it < NB * NE; it += GDIM) {
    const float* av = P->affT + (size_t)it * L;
    __syncthreads();
    for (int i = tid; i < L; i += NTHREADS) keys[i] = __float_as_uint(av[i]);
    uint32_t prefix = 0, mask = 0;
    int kth = CAP;
    for (int pass = 3; pass >= 0; --pass) {
      int shift = pass * 8;
      if (tid < 256) hist[tid] = 0;
      __syncthreads();
      if (pass == 3) {
        for (int i = tid; i < L; i += NTHREADS) {
          const int bin = (int)(keys[i] >> 24);
          unsigned long long todo = __ballot(1);
          while (todo) {
            const int leader = __builtin_ctzll(todo);
            const int v = __shfl(bin, leader);
            const unsigned long long same = __ballot(bin == v);
            if (lane == leader) atomicAdd(&hist[v], (int)__popcll(same));
            todo &= ~same;
          }
        }
      } else {
        for (int i = tid; i < L; i += NTHREADS) {
          uint32_t k = keys[i];
          if ((k & mask) == prefix) atomicAdd(&hist[(k >> shift) & 255], 1);
        }
      }
      __syncthreads();
      if (wid == 0) {
        int h0 = hist[4 * lane], h1 = hist[4 * lane + 1], h2 = hist[4 * lane + 2], h3 = hist[4 * lane + 3];
        int tot4 = h0 + h1 + h2 + h3;
        int suf = tot4;
#pragma unroll
        for (int o = 1; o < 64; o <<= 1) {
          int v = __shfl_down(suf, o);
          if (lane + o < 64) suf += v;
        }
        int above = suf - tot4;
        int c3 = above, c2 = c3 + h3, c1 = c2 + h2, c0 = c1 + h1;
        int selbin = -1, selrem = 0;
        if (c3 < kth && c3 + h3 >= kth) { selbin = 4 * lane + 3; selrem = kth - c3; }
        else if (c2 < kth && c2 + h2 >= kth) { selbin = 4 * lane + 2; selrem = kth - c2; }
        else if (c1 < kth && c1 + h1 >= kth) { selbin = 4 * lane + 1; selrem = kth - c1; }
        else if (c0 < kth && c0 + h0 >= kth) { selbin = 4 * lane; selrem = kth - c0; }
        if (selbin >= 0) { misc[0] = selbin; misc[1] = selrem; }
      }
      __syncthreads();
      prefix |= ((uint32_t)misc[0]) << shift;
      mask |= 0xFFu << shift;
      kth = misc[1];
      __syncthreads();
    }
    const uint32_t Tk = prefix;
    int cg_ = 0, ce_ = 0;
#pragma unroll
    for (int j = 0; j < 16; ++j) {
      uint32_t k = keys[tid * 16 + j];
      cg_ += (k > Tk);
      ce_ += (k == Tk);
    }
    int packed = cg_ | (ce_ << 16);
    int incl = packed;
#pragma unroll
    for (int o = 1; o < 64; o <<= 1) {
      int nbv = __shfl_up(incl, o);
      if (lane >= o) incl += nbv;
    }
    if (lane == 63) misc[8 + wid] = incl;
    __syncthreads();
    int woff = 0, tot = 0;
    for (int w = 0; w < 8; ++w) {
      int v = misc[8 + w];
      if (w < wid) woff += v;
      tot += v;
    }
    int excl = woff + incl - packed;
    int pg = excl & 0xFFFF, pe = excl >> 16;
    int total_gt = tot & 0xFFFF;
    int* oi = P->idx + it * CAP;
    float* og = P->gsel + it * CAP;
    int* ts = P->tokslot + (size_t)it * L;
#pragma unroll
    for (int j = 0; j < 16; ++j) {
      int i = tid * 16 + j;
      uint32_t k = keys[i];
      int slot = -1;
      if (k > Tk) {
        slot = pg; ++pg;
      } else if (k == Tk) {
        if (pe < kth) slot = total_gt + pe;
        ++pe;
      }
      if (slot >= 0) { oi[slot] = i; og[slot] = __uint_as_float(k); }
      ts[i] = slot;
    }
  }
}

__device__ __forceinline__ void phase_moe_combine_rms(KP P, const float* g) {
  LAUNDER_IDS
  const int lane = TIDX & 63;
  const int gw = BIDX * 8 + (TIDX >> 6), nw = GDIM * 8;
#define CMB_SLOT(r_) ((lane < NE) ? P->tokslot[((size_t)((r_) / L) * NE + lane) * L + ((r_) % L)] : -1)
#define CMB_FIRST(slotv_, b_, q0_, q1_, cnt_, rest_) do { \
    unsigned long long _sel = __ballot((slotv_) >= 0) & 0xffffull; cnt_ = 0; \
    if (_sel) { const int _e0 = __builtin_ctzll(_sel); _sel &= _sel - 1; const int _s0 = __shfl((slotv_), _e0); \
      const bf16_t* _y0 = P->Ybuf + (((size_t)(b_) * NE + _e0) * CAP + _s0) * D; \
      _Pragma("unroll") for (int i = 0; i < 4; ++i) q0_[i] = *(const u32x2*)(_y0 + i * 256 + lane * 4); cnt_ = 1; \
      if (_sel) { const int _e1 = __builtin_ctzll(_sel); _sel &= _sel - 1; const int _s1 = __shfl((slotv_), _e1); \
        const bf16_t* _y1 = P->Ybuf + (((size_t)(b_) * NE + _e1) * CAP + _s1) * D; \
        _Pragma("unroll") for (int i = 0; i < 4; ++i) q1_[i] = *(const u32x2*)(_y1 + i * 256 + lane * 4); cnt_ = 2; } } \
    rest_ = _sel; } while (0)
  f32x4 nxv[4];
  u32x2 pa0[4], pa1[4];
  int slotA, slotB, pcnt;
  unsigned long long prest;
  {
    const int r0 = (gw < T) ? gw : 0;
    const int r1 = (r0 + nw < T) ? (r0 + nw) : r0;
#pragma unroll
    for (int i = 0; i < 4; ++i) { nxv[i] = *(const f32x4*)(P->xcur + (size_t)r0 * D + i * 256 + lane * 4); pa0[i] = u32x2{0u, 0u}; pa1[i] = u32x2{0u, 0u}; }
    slotA = CMB_SLOT(r0);
    slotB = CMB_SLOT(r1);
    CMB_FIRST(slotA, r0 / L, pa0, pa1, pcnt, prest);
  }
  for (int row = gw; row < T; row += nw) {
    const int b = row / L;
    float* xr = P->xcur + (size_t)row * D;
    f32x4 v[4];
#pragma unroll
    for (int i = 0; i < 4; ++i) v[i] = nxv[i];
    const int myslot = slotA;
    const int nr = (row + nw < T) ? (row + nw) : row;
    const int nr2 = (nr + nw < T) ? (nr + nw) : nr;
#pragma unroll
    for (int i = 0; i < 4; ++i) nxv[i] = *(const f32x4*)(P->xcur + (size_t)nr * D + i * 256 + lane * 4);
    const int slotC = CMB_SLOT(nr2);
    u32x2 na0[4], na1[4];
    int ncnt; unsigned long long nrest;
#pragma unroll
    for (int i = 0; i < 4; ++i) { na0[i] = u32x2{0u, 0u}; na1[i] = u32x2{0u, 0u}; }
    CMB_FIRST(slotB, nr / L, na0, na1, ncnt, nrest);
    if (pcnt >= 1) {
#pragma unroll
      for (int i = 0; i < 4; ++i) v[i] += unpack4(pa0[i]);
    }
    if (pcnt == 2) {
#pragma unroll
      for (int i = 0; i < 4; ++i) v[i] += unpack4(pa1[i]);
    }
    unsigned long long sel = prest;
    while (sel) {
      const int e0 = __builtin_ctzll(sel); sel &= sel - 1;
      const bool two = sel != 0;
      const int e1 = two ? __builtin_ctzll(sel) : e0;
      if (two) sel &= sel - 1;
      const int sl0 = __shfl(myslot, e0), sl1 = __shfl(myslot, e1);
      const bf16_t* y0 = P->Ybuf + (((size_t)b * NE + e0) * CAP + sl0) * D;
      const bf16_t* y1 = P->Ybuf + (((size_t)b * NE + e1) * CAP + sl1) * D;
      u32x2 a0[4], a1[4];
#pragma unroll
      for (int i = 0; i < 4; ++i) a0[i] = *(const u32x2*)(y0 + i * 256 + lane * 4);
      if (two) {
#pragma unroll
        for (int i = 0; i < 4; ++i) a1[i] = *(const u32x2*)(y1 + i * 256 + lane * 4);
      }
#pragma unroll
      for (int i = 0; i < 4; ++i) v[i] += unpack4(a0[i]);
      if (two) {
#pragma unroll
        for (int i = 0; i < 4; ++i) v[i] += unpack4(a1[i]);
      }
    }
    float ss = 0.f;
#pragma unroll
    for (int i = 0; i < 4; ++i) {
      *(f32x4*)(xr + i * 256 + lane * 4) = v[i];
      ss += v[i][0] * v[i][0] + v[i][1] * v[i][1] + v[i][2] * v[i][2] + v[i][3] * v[i][3];
    }
    ss = wave_sum(ss);
    const float rs = rsqrtf(ss * (1.f / D) + EPS);
    bf16_t* ao = P->A1 + (size_t)row * D;
#pragma unroll
    for (int i = 0; i < 4; ++i) {
      const int c = i * 256 + lane * 4;
      f32x4 g4 = *(const f32x4*)(g + c);
      u32x2 o = {pack2(v[i][0] * rs * g4[0], v[i][1] * rs * g4[1]), pack2(v[i][2] * rs * g4[2], v[i][3] * rs * g4[3])};
      *(u32x2*)(ao + c) = o;
    }
    slotA = slotB; slotB = slotC; pcnt = ncnt; prest = nrest;
#pragma unroll
    for (int i = 0; i < 4; ++i) { pa0[i] = na0[i]; pa1[i] = na1[i]; }
  }
#undef CMB_SLOT
#undef CMB_FIRST
}

__device__ __forceinline__ void phase_final(KP P) {
  LAUNDER_IDS
  const int lane = TIDX & 63;
  const int gw = BIDX * 8 + (TIDX >> 6), nw = GDIM * 8;
  if (gw >= T) return;
  const float* xsrc = P->xcur;
  f32x4 cur[4], nx[4];
#pragma unroll
  for (int i = 0; i < 4; ++i) cur[i] = *(const f32x4*)(xsrc + (size_t)gw * D + i * 256 + lane * 4);
  for (int row = gw; row < T; row += nw) {
    const int nr = (row + nw < T) ? (row + nw) : row;
#pragma unroll
    for (int i = 0; i < 4; ++i) nx[i] = *(const f32x4*)(xsrc + (size_t)nr * D + i * 256 + lane * 4);
    float ss = 0.f;
#pragma unroll
    for (int i = 0; i < 4; ++i) ss += cur[i][0] * cur[i][0] + cur[i][1] * cur[i][1] + cur[i][2] * cur[i][2] + cur[i][3] * cur[i][3];
    ss = wave_sum(ss);
    const float rs = rsqrtf(ss * (1.f / D) + EPS);
#pragma unroll
    for (int i = 0; i < 4; ++i) {
      const int c = i * 256 + lane * 4;
      f32x4 g4 = *(const f32x4*)(P->final_norm + c);
      *(f32x4*)(P->out + (size_t)row * D + c) = cur[i] * g4 * rs;
    }
#pragma unroll
    for (int i = 0; i < 4; ++i) cur[i] = nx[i];
  }
}

__global__ void __launch_bounds__(NTHREADS, 2) mega(Params Pval) {
  extern __shared__ __attribute__((aligned(16))) char smem[];
  cg::grid_group grid = cg::this_grid();
  float* smf = (float*)smem;
  KP P = (KP)__builtin_amdgcn_kernarg_segment_ptr();
  volatile XLAS unsigned* xst = (volatile XLAS unsigned*)(smem + SMEM_USER);
  if (threadIdx.x == 0) { xst[0] = 0u; xst[1] = 0u; xst[2] = 0u; xst[3] = 0u; }
  __syncthreads();
  (void)xcd_barrier_post(P->bar, xst);
#define XBAR() do { LND(); XcdBarrier _xb; _xb.bar = P->bar; _xb.x = xb_xcc_id(); _xb.st = (volatile XLAS unsigned*)(smem + SMEM_USER); xcd_barrier(_xb); } while (0)
#define LND() asm volatile("" : "+s"(P) : : "memory")
#define LAYER(ly) do { \
    LND(); phase_convert(P, ly, smf); \
    LND(); phase_rms_x(P, (ly == 0) ? P->x : P->xcur, P->norm_mix + ly * D, P->A1); \
    if (ly == 0) grid.sync(); else XBAR(); \
    LND(); phase_g8_inproj(P, ly, smem); \
    LND(); phase_filters(P, ly, smf, 64); \
    XBAR(); \
    LND(); phase_gemm_qkv(P, smem); \
    LND(); phase_ssd1(P, ly, smem); \
    LND(); phase_hyena_fft(P, ly, (float2*)smem); \
    XBAR(); \
    LND(); phase_ssd_scan(P); \
    XBAR(); \
    LND(); phase_attn_mfma(P, smem); \
    LND(); phase_ssd3(P, ly, smem); \
    XBAR(); \
    LND(); phase_prep4(P, ly, smf); \
    XBAR(); \
    LND(); phase_g8_out(P, ly, smem); \
    XBAR(); \
    LND(); phase_prep5(P, ly, smf); \
    XBAR(); \
    LND(); phase_topk(P, smem); \
    LND(); phase_g8_pp(P, smem); \
    LND(); phase_convert_gu(P, ly, smem); \
    XBAR(); \
    LND(); phase_g8_moe1(P, smem); \
    XBAR(); \
    LND(); phase_g8_moe2(P, smem); \
    XBAR(); \
    LND(); phase_moe_combine_rms(P, P->ple_norm + ly * D); \
    XBAR(); \
    LND(); phase_g8_ple(P, smem); \
    XBAR(); \
  } while (0)
  LAYER(0);
  LAYER(1);
  LND(); phase_final(P);
}

extern "C" void kernel_launch(void* const* d_in, const int* in_sizes, int n_in, void* d_out, int out_size, void* d_ws,
                              size_t ws_size, hipStream_t stream) {
  static int grid_blocks = 0;
  if (!grid_blocks) {
    int dev = 0, cus = 0, per_cu = 0;
    (void)hipGetDevice(&dev);
    (void)hipDeviceGetAttribute(&cus, hipDeviceAttributeMultiprocessorCount, dev);
    (void)hipFuncSetAttribute((const void*)mega, hipFuncAttributeMaxDynamicSharedMemorySize, SMEM_BYTES);
    (void)hipOccupancyMaxActiveBlocksPerMultiprocessor(&per_cu, mega, NTHREADS, SMEM_BYTES);
    if (per_cu < 1) per_cu = 1;
    if (per_cu > 1) per_cu = 1;
    grid_blocks = cus * per_cu;
  }
  Params P;
  memset(&P, 0, sizeof(P));
  const float* const* in = (const float* const*)d_in;
  P.x = in[0]; P.p = in[1]; P.pos = (const int*)d_in[2];
  P.norm_mix = in[3]; P.w_in = in[4]; P.q_norm = in[5]; P.w_uq = in[6]; P.kv_norm = in[7]; P.w_ukv = in[8];
  P.mla_out_norm = in[9]; P.hy_conv_w = in[10]; P.hy_conv_b = in[11]; P.hy_w1 = in[12]; P.hy_b1 = in[13]; P.hy_freq = in[14];
  P.hy_w2 = in[15]; P.hy_b2 = in[16]; P.hy_w3 = in[17]; P.hy_decay = in[18]; P.hy_bias = in[19]; P.hy_out_norm = in[20];
  P.ssm_conv_w = in[21]; P.ssm_conv_b = in[22]; P.ssm_dt_bias = in[23]; P.ssm_a_log = in[24]; P.ssm_d = in[25]; P.ssm_norm = in[26];
  P.w_out = in[27]; P.norm_ffn = in[28]; P.router = in[29]; P.w_gate = in[30]; P.w_up = in[31]; P.w_down = in[32];
  P.ple_norm = in[33]; P.ple_gate_w = in[34]; P.ple_proj = in[35]; P.final_norm = in[36];
  P.out = (float*)d_out;
  char* w = (char*)d_ws;
  size_t off = 0;
  auto take = [&](size_t bytes) { char* r = w + off; off += (bytes + 255) & ~(size_t)255; return r; };
  P.Win_t = (bf16_t*)take((size_t)NINP * D * 2);
  P.Wuq_t = (bf16_t*)take((size_t)768 * 256 * 2);
  P.Wukv_t = (bf16_t*)take((size_t)1024 * 128 * 2);
  P.Wout_t = (bf16_t*)take((size_t)D * D * 2);
  P.Wgu_t = (bf16_t*)take((size_t)NE * 2 * FF * D * 2);
  P.Wd_t = (bf16_t*)take((size_t)NE * D * FF * 2);
  P.Wpg_t = (bf16_t*)take((size_t)D * D * 2);
  P.Wpp_t = (bf16_t*)take((size_t)D * 256 * 2);
  P.xcur = (float*)take((size_t)T * D * 4);
  P.A1 = (bf16_t*)take((size_t)T * D * 2);
  size_t r1 = (size_t)T * NIN * 4;
  char* R1 = take(r1);
  P.proj = (float*)R1;
  P.H = (bf16_t*)R1;
  P.Aq = (bf16_t*)take((size_t)T * 256 * 2);
  P.Akv = (bf16_t*)take((size_t)T * 128 * 2);
  char* R2 = take((size_t)T * 768 * 4 + (size_t)T * 1024 * 4);
  P.qraw = (float*)R2;
  P.kvraw = (float*)(R2 + (size_t)T * 768 * 4);
  P.PP = (float*)R2;
  P.PPb = (bf16_t*)R2;
  P.Ap = (bf16_t*)(R2 + (size_t)T * 1024 * 4);
  P.Qb = (bf16_t*)take((size_t)T * 768 * 2);
  P.Kn = (bf16_t*)take((size_t)T * 512 * 2);
  P.Kr = (bf16_t*)take((size_t)T * 32 * 2);
  P.Vt = (bf16_t*)take((size_t)T * 512 * 2);
  P.oattn = (bf16_t*)take((size_t)T * 512 * 2);
  P.huT = (float*)take((size_t)T * 768 * 4);
  P.filtT = (_Float16*)take((size_t)1024 * L * 2);
  P.v1T = (float*)take((size_t)T * 256 * 4);
  P.ohyT = (float*)take((size_t)T * 256 * 4);
  P.KFb = (h16x2*)take((size_t)256 * 2 * FFT_N * 4);
  P.xbc = (float*)take((size_t)T * 768 * 4);
  P.xbcr = (bf16_t*)take((size_t)T * 768 * 2);
  P.ssq_q = (float*)take((size_t)T * 4 * 4);
  P.ssq_kv = (float*)take((size_t)T * 4 * 4);
  P.dtv = (float*)take((size_t)T * 8 * 4);
  P.zbuf = (bf16_t*)take((size_t)T * 256 * 2);
  P.yf = (float*)take((size_t)T * 256 * 4);
  P.yb = (float*)take((size_t)T * 256 * 4);
  P.states = (float*)take((size_t)1024 * 8192 * 4);
  P.prevb = (bf16_t*)take((size_t)1024 * 8192 * 2);
  P.cdec = (float*)take((size_t)1024 * 4);
  P.bar = (unsigned*)take((size_t)XCD_BAR_WORDS * 4);
  P.affT = (float*)take((size_t)NB * NE * L * 4);
  P.idx = (int*)take((size_t)NB * NE * CAP * 4);
  P.tokslot = (int*)take((size_t)NB * NE * L * 4);
  P.Ybuf = (bf16_t*)P.huT;
  P.gsel = (float*)take((size_t)NB * NE * CAP * 4);
  if (off > ws_size) {
    fprintf(stderr, "kernel_launch: workspace too small: need %zu have %zu\n", off, ws_size);
    return;
  }
  (void)hipMemsetAsync(P.bar, 0, (size_t)XCD_BAR_WORDS * 4, stream);
  void* args[] = {&P};
  hipError_t e = hipLaunchCooperativeKernel((void*)mega, dim3(grid_blocks), dim3(NTHREADS), args, SMEM_BYTES, stream);
  if (e != hipSuccess) fprintf(stderr, "cooperative launch failed: %s (grid %d)\n", hipGetErrorString(e), grid_blocks);
}
```

```cpp
#include <hip/hip_runtime.h>
#include <hip/hip_cooperative_groups.h>
#include <stdint.h>
#include <stdio.h>
#include <string.h>
namespace cg = cooperative_groups;

typedef unsigned short bf16_t;
using bf16x8 = __attribute__((ext_vector_type(8))) short;
using f32x4 = __attribute__((ext_vector_type(4))) float;
using u32x4 = __attribute__((ext_vector_type(4))) unsigned int;
using u32x2 = __attribute__((ext_vector_type(2))) unsigned int;
using f32x16 = __attribute__((ext_vector_type(16))) float;
using s16x4 = __attribute__((ext_vector_type(4))) short;
typedef __bf16 bf16v2_t __attribute__((ext_vector_type(2)));
typedef float f32v2_t __attribute__((ext_vector_type(2)));
typedef _Float16 h16x2 __attribute__((ext_vector_type(2)));
typedef _Float16 h16x8 __attribute__((ext_vector_type(8)));

constexpr int NB = 2, L = 8192, D = 1024, T = NB * L, DEPTH = 2;
constexpr int NIN = 2216, NINP = 2304;
constexpr int C_CQ = 0, C_CKV = 256, C_KR = 384, C_HY = 416, C_Z = 1184, C_XBC = 1440, C_DT = 2208;
constexpr int NE = 16, FF = 2048, CAP = 1024;
constexpr float EPS = 1e-6f;
constexpr int NTHREADS = 512;
constexpr int SMEM_USER = 139264;
constexpr int SMEM_BYTES = SMEM_USER + 16;

struct Params {
  const float* x; const float* p; const int* pos;
  const float* norm_mix; const float* w_in; const float* q_norm; const float* w_uq; const float* kv_norm; const float* w_ukv;
  const float* mla_out_norm; const float* hy_conv_w; const float* hy_conv_b; const float* hy_w1; const float* hy_b1; const float* hy_freq;
  const float* hy_w2; const float* hy_b2; const float* hy_w3; const float* hy_decay; const float* hy_bias; const float* hy_out_norm;
  const float* ssm_conv_w; const float* ssm_conv_b; const float* ssm_dt_bias; const float* ssm_a_log; const float* ssm_d; const float* ssm_norm;
  const float* w_out; const float* norm_ffn; const float* router; const float* w_gate; const float* w_up; const float* w_down;
  const float* ple_norm; const float* ple_gate_w; const float* ple_proj; const float* final_norm;
  float* out;
  bf16_t *Win_t, *Wuq_t, *Wukv_t, *Wout_t, *Wgu_t, *Wd_t, *Wpg_t, *Wpp_t;
  float* xcur; bf16_t* A1; float* proj; bf16_t* Aq; bf16_t* Akv; float* qraw; float* kvraw;
  bf16_t *Qb, *Kn, *Kr, *Vt; bf16_t* oattn; float* huT; _Float16* filtT; float *v1T, *ohyT; h16x2* KFb; float *xbc; bf16_t* xbcr; float* dtv; bf16_t* zbuf; float *yf, *yb; float *ssq_q, *ssq_kv; float *states, *cdec; bf16_t* prevb;
  unsigned* bar; float* affT; int* idx; int* tokslot; bf16_t* Ybuf; bf16_t* PPb; float* gsel; bf16_t* H; bf16_t* Ap; float* PP;
};

typedef const Params __attribute__((address_space(4)))* KP;

__device__ __forceinline__ int tid_() { int t = threadIdx.x; asm volatile("" : "+v"(t)); return t; }
__device__ __forceinline__ int bid_() { int b = blockIdx.x; asm volatile("" : "+s"(b)); return b; }
__device__ __forceinline__ int gdim_() { int b = gridDim.x; asm volatile("" : "+s"(b)); return b; }
#define LAUNDER_IDS const int TIDX = tid_(); const int BIDX = bid_(); const int GDIM = gdim_(); (void)TIDX; (void)BIDX; (void)GDIM;

__device__ __forceinline__ bf16_t f2bf(float f) {
  __bf16 h = (__bf16)f;
  return __builtin_bit_cast(bf16_t, h);
}
__device__ __forceinline__ uint32_t pack2(float a, float b) {
  f32v2_t v = {a, b};
  bf16v2_t r = __builtin_convertvector(v, bf16v2_t);
  return __builtin_bit_cast(uint32_t, r);
}
__device__ __forceinline__ f32x4 unpack4(u32x2 y) {
  f32x4 r = {__uint_as_float(y[0] << 16), __uint_as_float(y[0] & 0xffff0000u), __uint_as_float(y[1] << 16), __uint_as_float(y[1] & 0xffff0000u)};
  return r;
}
__device__ __forceinline__ float wave_sum(float v) {
#pragma unroll
  for (int o = 32; o; o >>= 1) v += __shfl_xor(v, o);
  return v;
}
__device__ __forceinline__ float sigmf(float a) { return __builtin_amdgcn_rcpf(1.f + __expf(-a)); }
__device__ __forceinline__ float siluf(float a) { return a * sigmf(a); }
__device__ __forceinline__ void rope_cs(int pos, int j, float& cs, float& sn) {
  float invf = exp2f(-(float)(2 * j) * (13.287712379549449f / 32.f));
  float ang = (float)pos * invf;
  double rev = (double)ang * 0.15915494309189535;
  rev -= floor(rev);
  float ar = (float)rev * 6.283185307179586f;
  cs = __cosf(ar);
  sn = __sinf(ar);
}


#define XB_TMO      128
#define XB_XCNT(j)  (256  + 64 * (j))
#define XB_XSUB(j)  (1280 + 64 * (j))
#define XB_XGEN(j)  (2304 + 64 * (j))
#define XB_TOP      3328
#define XB_TOPGEN   3392
#define XCD_BAR_WORDS 3456
#define XB_SPIN_CAP (1u << 20)
#define XLAS __attribute__((address_space(3)))
__device__ __forceinline__ unsigned xb_ld(unsigned* p)              { return __hip_atomic_load(p, __ATOMIC_RELAXED, __HIP_MEMORY_SCOPE_AGENT); }
__device__ __forceinline__ unsigned xb_add(unsigned* p, unsigned v) { return __hip_atomic_fetch_add(p, v, __ATOMIC_RELAXED, __HIP_MEMORY_SCOPE_AGENT); }
__device__ __forceinline__ unsigned xb_xcc_id() { return (unsigned)__builtin_amdgcn_s_getreg((3 << 11) | 20) & 0xFu; }
#define XB_SPIN(cond, bar) do { unsigned _sp = 0; while (cond) { __builtin_amdgcn_s_sleep(1); \
    if ((++_sp & 255u) == 0u) { if (xb_ld(&(bar)[XB_TMO])) break; if (_sp > XB_SPIN_CAP) { atomicAdd(&(bar)[XB_TMO], 1u); break; } } } } while (0)
struct XcdBarrier { unsigned* bar; unsigned x; volatile XLAS unsigned* st; };
__device__ __forceinline__ XcdBarrier xcd_barrier_post(unsigned* bar, volatile XLAS unsigned* st) {
  XcdBarrier b; b.bar = bar; b.x = xb_xcc_id(); b.st = st;
  if (threadIdx.x == 0) (void)xb_add(&bar[XB_XCNT(b.x)], 1u);
  return b;
}
__device__ __forceinline__ void xcd_barrier_complete(unsigned* bar, unsigned x, unsigned& nloc, unsigned& nx) {
  const unsigned G = gridDim.x * gridDim.y * gridDim.z;
  unsigned sum, cnt, mine, sp = 0u;
  for (;;) {
    sum = 0u; cnt = 0u; mine = 0u;
#pragma unroll
    for (unsigned j = 0; j < 16; ++j) { const unsigned c = xb_ld(&bar[XB_XCNT(j)]); sum += c; cnt += (c > 0u) ? 1u : 0u; mine = (j == x) ? c : mine; }
    if (sum == G) break;
    __builtin_amdgcn_s_sleep(1);
    if ((++sp & 255u) == 0u) { if (xb_ld(&bar[XB_TMO])) break; if (sp > XB_SPIN_CAP) { atomicAdd(&bar[XB_TMO], 1u); break; } }
  }
  nloc = mine > 0u ? mine : 1u; nx = cnt > 0u ? cnt : 1u;
}
__device__ __forceinline__ void xcd_barrier(const XcdBarrier& b) {
  asm volatile("s_waitcnt vmcnt(0)" ::: "memory");
  __syncthreads();
  if (threadIdx.x == 0) {
    unsigned* bar = b.bar;
    __builtin_amdgcn_s_waitcnt(0);
    unsigned nloc = b.st[0], nx = b.st[1];
    if (nloc == 0u) { xcd_barrier_complete(bar, b.x, nloc, nx); b.st[0] = nloc; b.st[1] = nx; }
    const unsigned old = xb_add(&bar[XB_XSUB(b.x)], 1u);
    const unsigned gen = old / nloc;
    if (old + 1u == (gen + 1u) * nloc) {
      __builtin_amdgcn_fence(__ATOMIC_RELEASE, "agent");
      asm volatile("s_waitcnt vmcnt(0)" ::: "memory");
      const unsigned og = xb_add(&bar[XB_TOP], 1u);
      const unsigned tg = og / nx;
      if (og + 1u == (tg + 1u) * nx) xb_add(&bar[XB_TOPGEN], 1u);
      else XB_SPIN(xb_ld(&bar[XB_TOPGEN]) == tg, bar);
      __builtin_amdgcn_fence(__ATOMIC_ACQUIRE, "agent");
      xb_add(&bar[XB_XGEN(b.x)], 1u);
      asm volatile("s_waitcnt vmcnt(0)" ::: "memory");
    } else {
      XB_SPIN(xb_ld(&bar[XB_XGEN(b.x)]) == gen, bar);
      __builtin_amdgcn_fence(__ATOMIC_ACQUIRE, "agent");
      asm volatile("s_waitcnt vmcnt(0)" ::: "memory");
    }
  }
  __syncthreads();
}

__device__ __forceinline__ void convert_T(const float* __restrict__ src, bf16_t* dst, int K, int N, int Npad, int batch, size_t sstride,
                          size_t dstride, int mode, float* tile) {
  LAUNDER_IDS
  const int kt = K / 64, nt = Npad / 64;
  const int total = batch * kt * nt;
  for (int t = BIDX; t < total; t += GDIM) {
    int bi = t / (kt * nt);
    int r = t % (kt * nt);
    int ki = r / nt, ni = r % nt;
    const float* s = src + (size_t)bi * sstride;
    bf16_t* d = dst + (size_t)bi * dstride;
    __syncthreads();
    for (int i = TIDX; i < 64 * 64; i += NTHREADS) {
      int kk = i >> 6, nn = i & 63;
      int n = ni * 64 + nn;
      tile[kk * 65 + nn] = (n < N) ? s[(size_t)(ki * 64 + kk) * N + n] : 0.f;
    }
    __syncthreads();
    for (int i = TIDX; i < 64 * 32; i += NTHREADS) {
      int nn = i >> 5, k2 = (i & 31) * 2;
      int n = ni * 64 + nn;
      const int cc_ = n & 31;
      const int rho_ = ((cc_ >> 2) & 1) * 16 + (cc_ >> 3) * 4 + (cc_ & 3);
      int drow;
      if (mode == 0) drow = n;
      else if (mode == 4) drow = (n & ~31) + rho_;
      else drow = (n >> 7) * 256 + ((mode == 2) ? 128 : 0) + ((n & 127) & ~31) + rho_;
      uint32_t pk = pack2(tile[k2 * 65 + nn], tile[(k2 + 1) * 65 + nn]);
      *(uint32_t*)(d + (size_t)drow * K + ki * 64 + k2) = pk;
    }
  }
}

__device__ __forceinline__ void convert_T2(const float* __restrict__ src, bf16_t* dst, int K, int N, int Npad, int batch, size_t sstride,
                           size_t dstride, int mode, char* sm, const float* __restrict__ gk = nullptr, int vb0 = 0, int vgrid = 0) {
  LAUNDER_IDS
  const int kt = K / 64, nt = Npad / 256;
  const int total = batch * kt * nt;
  const int n4 = TIDX & 63, kq = TIDX >> 6;
  const int VG = vgrid ? vgrid : GDIM;
  if (BIDX < vb0 || BIDX >= vb0 + VG) return;
  int t = BIDX - vb0;
  if (t >= total) return;
  f32x4 r[8];
#define CONV_LOAD(tt) do { int _bi = (tt) / (kt * nt); int _r = (tt) % (kt * nt); int _ki = _r / nt, _ni = _r % nt; const int _n = _ni * 256 + n4 * 4; \
    if (_n < N) { const float* sp = src + (size_t)_bi * sstride + (size_t)(_ki * 64 + kq * 4) * N + _n; \
      _Pragma("unroll") for (int _q = 0; _q < 4; ++_q) { r[_q] = __builtin_nontemporal_load((const f32x4*)(sp + (size_t)_q * N)); r[4 + _q] = __builtin_nontemporal_load((const f32x4*)(sp + (size_t)(32 + _q) * N)); } \
    } else { _Pragma("unroll") for (int _q = 0; _q < 8; ++_q) r[_q] = f32x4{0.f, 0.f, 0.f, 0.f}; } } while (0)
  CONV_LOAD(t);
  for (; t < total; t += VG) {
    int bi = t / (kt * nt);
    int rr = t % (kt * nt);
    int ki = rr / nt, ni = rr % nt;
    __syncthreads();
    if (gk) {
      f32x4 g0 = *(const f32x4*)(gk + ki * 64 + kq * 4), g1 = *(const f32x4*)(gk + ki * 64 + 32 + kq * 4);
#pragma unroll
      for (int q = 0; q < 4; ++q) { r[q] *= g0[q]; r[4 + q] *= g1[q]; }
    }
    const int key = n4 & 15;
#pragma unroll
    for (int j = 0; j < 4; ++j) {
      u32x2 v0 = {pack2(r[0][j], r[1][j]), pack2(r[2][j], r[3][j])};
      u32x2 v1 = {pack2(r[4][j], r[5][j]), pack2(r[6][j], r[7][j])};
      char* rowp = sm + (n4 * 4 + j) * 128;
      *(u32x2*)(rowp + ((kq ^ key) << 3)) = v0;
      *(u32x2*)(rowp + (((kq + 8) ^ key) << 3)) = v1;
    }
    __syncthreads();
    if (t + VG < total) CONV_LOAD(t + VG);
    bf16_t* d = dst + (size_t)bi * dstride;
#pragma unroll
    for (int c = TIDX; c < 2048; c += NTHREADS) {
      int row = c >> 3, ch = c & 7;
      const int key2 = (row >> 2) & 15;
      u32x2 a = *(const u32x2*)(sm + row * 128 + (((2 * ch) ^ key2) << 3));
      u32x2 bq = *(const u32x2*)(sm + row * 128 + (((2 * ch + 1) ^ key2) << 3));
      int n = ni * 256 + row;
      const int cc_ = n & 31;
      const int rho_ = ((cc_ >> 2) & 1) * 16 + (cc_ >> 3) * 4 + (cc_ & 3);
      int drow;
      if (mode == 0) drow = n;
      else if (mode == 4) drow = (n & ~31) + rho_;
      else drow = (n >> 7) * 256 + ((mode == 2) ? 128 : 0) + ((n & 127) & ~31) + rho_;
      u32x4 v = {a[0], a[1], bq[0], bq[1]};
      *(u32x4*)(d + (size_t)drow * K + ki * 64 + ch * 8) = v;
    }
  }
#undef CONV_LOAD
}

constexpr int BM = 256, BN = 128, BK = 64, LROW = 144;

template <int TMODE = 0, int NW16 = 4, class Epi>
__device__ __forceinline__ void gemm_tile(const bf16_t* A, int lda, const int* gidx, const bf16_t* Bt, int ldb, int K,
                                          char* smem, Epi epi) {
  LAUNDER_IDS
  const int tid = TIDX, lane = tid & 63, wid = __builtin_amdgcn_readfirstlane(tid >> 6);
  const int wr = wid >> 1, wc = wid & 1;
  const int fr = lane & 15, fq = lane >> 4;
  char* sA = smem;
  char* sB = smem + BM * LROW;
  const bf16_t* ap[4];
  int aoff[4];
#pragma unroll
  for (int i = 0; i < 4; ++i) {
    int cid = tid + NTHREADS * i;
    int row = cid >> 3, ch = cid & 7;
    int grow = gidx ? gidx[row] : row;
    ap[i] = A + (size_t)grow * lda + ch * 8;
    aoff[i] = row * LROW + ch * 16;
  }
  constexpr int NBL = NW16 / 2;
  const bf16_t* bp[NBL];
  int boff[NBL];
#pragma unroll
  for (int i = 0; i < NBL; ++i) {
    int cid = tid + NTHREADS * i;
    int row = cid >> 3, ch = cid & 7;
    bp[i] = Bt + (size_t)row * ldb + ch * 8;
    boff[i] = row * LROW + ch * 16;
  }
  u32x4 ra[4], rb[NBL];
#pragma unroll
  for (int i = 0; i < 4; ++i) ra[i] = *(const u32x4*)(ap[i]);
#pragma unroll
  for (int i = 0; i < NBL; ++i) rb[i] = *(const u32x4*)(bp[i]);
  f32x4 acc[4][NW16];
#pragma unroll
  for (int m = 0; m < 4; ++m)
#pragma unroll
    for (int n = 0; n < NW16; ++n) acc[m][n] = f32x4{0.f, 0.f, 0.f, 0.f};
  const int nk = K / BK;
  for (int kt = 0; kt < nk; ++kt) {
    __syncthreads();
#pragma unroll
    for (int i = 0; i < 4; ++i) *(u32x4*)(sA + aoff[i]) = ra[i];
#pragma unroll
    for (int i = 0; i < NBL; ++i) *(u32x4*)(sB + boff[i]) = rb[i];
    __syncthreads();
    {
      const int kn = (kt + 1 < nk) ? (kt + 1) : kt;
#pragma unroll
      for (int i = 0; i < 4; ++i) ra[i] = *(const u32x4*)(ap[i] + kn * BK);
#pragma unroll
      for (int i = 0; i < NBL; ++i) rb[i] = *(const u32x4*)(bp[i] + kn * BK);
    }
#pragma unroll
    for (int ks = 0; ks < 2; ++ks) {
      bf16x8 af[4];
#pragma unroll
      for (int m = 0; m < 4; ++m) af[m] = *(const bf16x8*)(sA + (wr * 64 + m * 16 + fr) * LROW + ks * 64 + fq * 16);
#pragma unroll
      for (int n0 = 0; n0 < NW16; n0 += 2) {
        bf16x8 bfr[2];
#pragma unroll
        for (int n = 0; n < 2; ++n) bfr[n] = *(const bf16x8*)(sB + (wc * (NW16 * 16) + (n0 + n) * 16 + fr) * LROW + ks * 64 + fq * 16);
        if (TMODE == 1 || (TMODE == 2 && wc == 0)) {
#pragma unroll
          for (int m = 0; m < 4; ++m)
#pragma unroll
            for (int n = 0; n < 2; ++n) acc[m][n0 + n] = __builtin_amdgcn_mfma_f32_16x16x32_bf16(bfr[n], af[m], acc[m][n0 + n], 0, 0, 0);
        } else {
#pragma unroll
          for (int m = 0; m < 4; ++m)
#pragma unroll
            for (int n = 0; n < 2; ++n) acc[m][n0 + n] = __builtin_amdgcn_mfma_f32_16x16x32_bf16(af[m], bfr[n], acc[m][n0 + n], 0, 0, 0);
        }
      }
    }
  }
  if constexpr (TMODE == 1) epi(acc, wr * 64 + fr, wc * (NW16 * 16) + fq * 4);
  else if constexpr (TMODE == 2) { if (wc == 0) epi.t(acc, wr * 64 + fr, fq * 4); else epi(acc, wr * 64 + fq * 4, wc * 64 + fr); }
  else epi(acc, wr * 64 + fq * 4, wc * 64 + fr);
}

namespace g8 {
#define G8_LAS __attribute__((address_space(3)))
constexpr int GBM = 256, GBK = 64, GHALF = 128, HTB = GHALF * GBK * 2, STAGE_BYTES = 8 * HTB;
__device__ __forceinline__ int lds_byte(int r, int c) { const int st = (r >> 4) * 2 + (c >> 5), rr = r & 15, cc = c & 31, ob = rr * 64 + cc * 2; return st * 1024 + (ob ^ (((ob >> 9) & 1) << 5)); }
__device__ __forceinline__ void stage_rc(int b, int& R, int& C) { const int st = b / 1024, sb = b % 1024, swz = sb ^ (((sb >> 9) & 1) << 5); R = (st >> 1) * 16 + swz / 64; C = (st & 1) * 32 + (swz % 64) / 2; }

struct Unit { const char* A; const char* B; int row0, col0, grp, gslot; };

template <bool GATHER, class Sched, class Epi>
__device__ __forceinline__ void gemm_phase(G8_LAS unsigned char* lds, const int K, const int lda, const int ldb, const Sched& S, const Epi& E, const int tid) {
  const int wid = __builtin_amdgcn_readfirstlane(tid >> 6), lane = tid & 63, wr = wid >> 2, wc = wid & 3, fr = lane & 15, fq = lane >> 4;
  const int nt = K / GBK;
  unsigned voffB[2];
#pragma unroll
  for (int i = 0; i < 2; ++i) { int R_, C_; stage_rc(tid * 16 + i * 8192, R_, C_); voffB[i] = (unsigned)(R_ * ldb + C_) * 2u; }
  const size_t kstep = (size_t)(GBK * 2);
  const size_t hstepB = (size_t)GHALF * ldb * 2;
  const unsigned ldsw = (unsigned)wid * 1024u;
  const int aoff = lds_byte(wr * 64 + fr, fq * 8), boff = lds_byte(wc * 32 + fr, fq * 8);
  const G8_LAS int* gl = (const G8_LAS int*)(lds + STAGE_BYTES);
#define G8_SA(b, h) (((b) * 2 + (h)) * HTB)
#define G8_SB(b, h) ((4 + (b) * 2 + (h)) * HTB)
#define G8_STAGE(bufoff, gbase, voff) do { _Pragma("unroll") for (int _i = 0; _i < 2; ++_i) \
    __builtin_amdgcn_global_load_lds((const unsigned*)((const char*)(gbase) + (voff)[_i]), (G8_LAS unsigned*)(lds + (bufoff) + ldsw + _i * 8192), 16, 0, 0); } while (0)
#define G8_LDA(dst, b, h) do { _Pragma("unroll") for (int m = 0; m < 4; ++m) _Pragma("unroll") for (int k = 0; k < 2; ++k) dst[m][k] = *(const G8_LAS bf16x8*)(lds + G8_SA(b, h) + aoff + m * 2048 + k * 1024); } while (0)
#define G8_LDB(dst, b, h) do { _Pragma("unroll") for (int n = 0; n < 2; ++n) _Pragma("unroll") for (int k = 0; k < 2; ++k) dst[n][k] = *(const G8_LAS bf16x8*)(lds + G8_SB(b, h) + boff + n * 2048 + k * 1024); } while (0)
#define G8_MMA(ai, bj, At, Bt) do { __builtin_amdgcn_s_setprio(1); _Pragma("unroll") for (int m = 0; m < 4; ++m) _Pragma("unroll") for (int n = 0; n < 2; ++n) _Pragma("unroll") for (int k = 0; k < 2; ++k) \
    acc[ai][bj][m][n] = __builtin_amdgcn_mfma_f32_16x16x32_bf16(Bt[n][k], At[m][k], acc[ai][bj][m][n], 0, 0, 0); __builtin_amdgcn_s_setprio(0); } while (0)
#define G8_WAIT_V(n) asm volatile("s_waitcnt vmcnt(" #n ")" ::: "memory")
#define G8_WAIT_L(n) asm volatile("s_waitcnt lgkmcnt(" #n ")" ::: "memory")
#define G8_BAR __builtin_amdgcn_s_barrier()
#define G8_SCHED __builtin_amdgcn_sched_barrier(0)
#define G8_AOFFS(dst, u) do { int _tl = tid; asm volatile("" : "+v"(_tl)); _Pragma("unroll") for (int _i = 0; _i < 2; ++_i) { int _R, _C; stage_rc(_tl * 16 + _i * 8192, _R, _C); \
    _Pragma("unroll") for (int _h = 0; _h < 2; ++_h) { int _row = _h * GHALF + _R; if (GATHER) _row = gl[(u).gslot * 256 + _row]; dst[_h][_i] = (unsigned)(_row * lda + _C) * 2u; } } } while (0)
  Unit cur, nxt;
  int ui = 0;
  if (!S.next(0, cur)) return;
  f32x4 acc[2][2][4][2];
#pragma unroll
  for (int a = 0; a < 2; ++a)
#pragma unroll
    for (int b = 0; b < 2; ++b)
#pragma unroll
      for (int m = 0; m < 4; ++m)
#pragma unroll
        for (int n = 0; n < 2; ++n) acc[a][b][m][n] = (f32x4){0.f, 0.f, 0.f, 0.f};
  bf16x8 At[4][2], B0[2][2], B1[2][2];
  unsigned vAc[2][2];
  G8_AOFFS(vAc, cur);
  const char* cA = cur.A;
  const char* cB = cur.B;
  G8_STAGE(G8_SB(0, 0), cB, voffB); G8_STAGE(G8_SA(0, 0), cA, vAc[0]); G8_STAGE(G8_SB(0, 1), cB + hstepB, voffB); G8_STAGE(G8_SA(0, 1), cA, vAc[1]);
  if (wr == 1) G8_BAR;
  G8_WAIT_V(4); G8_BAR;
  G8_STAGE(G8_SB(1, 0), cB + kstep, voffB); G8_STAGE(G8_SA(1, 0), cA + kstep, vAc[0]); G8_STAGE(G8_SB(1, 1), cB + hstepB + kstep, voffB);
  G8_WAIT_V(6); G8_BAR;
  for (;;) {
    bool has_next = false;
    const char* nA = cA;
    const char* nB = cB;
#pragma unroll 1
    for (int t = 0; t < nt; t += 2) {
      const bool last = (t == nt - 2);
      if (last) { has_next = S.next(ui + 1, nxt); if (has_next) { nA = nxt.A; nB = nxt.B; } }
      const char* a1 = cA + (size_t)(t + 1) * kstep;
      const char* a2 = last ? nA : cA + (size_t)(t + 2) * kstep;
      const char* b2 = last ? nB : cB + (size_t)(t + 2) * kstep;
      const char* a3 = a2 + kstep;
      const char* b3 = b2 + kstep;
      G8_LDB(B0, 0, 0); G8_SCHED; G8_LDA(At, 0, 0); G8_STAGE(G8_SA(1, 1), a1, vAc[1]);
      G8_WAIT_L(8); G8_BAR; G8_WAIT_L(0); G8_MMA(0, 0, At, B0); G8_BAR; G8_SCHED;
      if (last && has_next) { G8_AOFFS(vAc, nxt); }
      G8_LDB(B1, 0, 1); G8_STAGE(G8_SB(0, 0), b2, voffB);
      G8_BAR; G8_WAIT_L(0); G8_MMA(0, 1, At, B1); G8_BAR;
      G8_LDA(At, 0, 1); G8_STAGE(G8_SA(0, 0), a2, vAc[0]);
      G8_BAR; G8_WAIT_L(0); G8_MMA(1, 0, At, B0); G8_BAR; G8_SCHED;
      G8_STAGE(G8_SB(0, 1), b2 + hstepB, voffB);
      G8_WAIT_V(6); G8_BAR; G8_MMA(1, 1, At, B1); G8_BAR;
      G8_LDB(B0, 1, 0); G8_SCHED; G8_LDA(At, 1, 0); G8_STAGE(G8_SA(0, 1), a2, vAc[1]);
      G8_WAIT_L(8); G8_BAR; G8_WAIT_L(0); G8_MMA(0, 0, At, B0); G8_BAR; G8_SCHED;
      G8_LDB(B1, 1, 1); G8_STAGE(G8_SB(1, 0), b3, voffB);
      G8_BAR; G8_WAIT_L(0); G8_MMA(0, 1, At, B1); G8_BAR;
      G8_LDA(At, 1, 1); G8_STAGE(G8_SA(1, 0), a3, vAc[0]);
      G8_BAR; G8_WAIT_L(0); G8_MMA(1, 0, At, B0); G8_BAR; G8_SCHED;
      G8_STAGE(G8_SB(1, 1), b3 + hstepB, voffB);
      G8_WAIT_V(6); G8_BAR; G8_MMA(1, 1, At, B1); G8_BAR;
    }
    E(acc, cur, wr, wc, fr, fq);
    if (!has_next) break;
#pragma unroll
    for (int a = 0; a < 2; ++a)
#pragma unroll
      for (int b = 0; b < 2; ++b)
#pragma unroll
        for (int m = 0; m < 4; ++m)
#pragma unroll
          for (int n = 0; n < 2; ++n) acc[a][b][m][n] = (f32x4){0.f, 0.f, 0.f, 0.f};
    cur = nxt; cA = nA; cB = nB; ++ui;
  }
  G8_WAIT_V(0);
  if (wr == 0) G8_BAR;
  G8_BAR;
#undef G8_SA
#undef G8_SB
#undef G8_STAGE
#undef G8_LDA
#undef G8_LDB
#undef G8_MMA
#undef G8_WAIT_V
#undef G8_WAIT_L
#undef G8_BAR
#undef G8_SCHED
#undef G8_AOFFS
}

struct DenseSched {
  const char* A; const char* B; int lda, ldb, nM, nN, nwg, G, c;
  __device__ __forceinline__ bool next(int i, Unit& u) const {
    const long Lx = (long)i * G + c;
    if (Lx >= nwg) return false;
    int wgid = (int)Lx;
    { const int q = nwg / 8, r = nwg % 8, xcd = wgid % 8, off = wgid / 8; wgid = (xcd < r ? xcd * (q + 1) : r * (q + 1) + (xcd - r) * q) + off; }
    const int nig = 8 * nN, gid = wgid / nig, fm = gid * 8, gsz = (nM - fm) < 8 ? (nM - fm) : 8;
    const int pm = fm + ((wgid % nig) % gsz), pn = (wgid % nig) / gsz;
    u.A = A + (size_t)pm * GBM * lda * 2; u.B = B + (size_t)pn * GBM * ldb * 2; u.row0 = pm * GBM; u.col0 = pn * GBM; u.grp = 0; u.gslot = 0;
    return true;
  }
};
struct MoeSched {
  const char* A; const char* B; int lda, ldb, nN, rounds, G, c; size_t strideA_g, strideB_e; bool gather;
  __device__ __forceinline__ bool next(int i, Unit& u) const {
    const long Lx = (long)i * G + c;
    if (Lx >= (long)rounds * 256) return false;
    const int rnd = (int)(Lx >> 8), cc = (int)(Lx & 255);
    const int x = cc & 7, j = cc >> 3;
    const int bt = rnd * 32 + x * 4 + (j >> 3), bpm = j & 7;
    const int b = bpm >> 2, pm = bpm & 3;
    const int e = bt / nN, pn = bt % nN;
    const int grp = b * NE + e;
    u.A = gather ? (A + (size_t)b * L * lda * 2) : (A + (size_t)grp * strideA_g + (size_t)pm * GBM * lda * 2);
    u.B = B + (size_t)e * strideB_e + (size_t)pn * GBM * ldb * 2;
    u.row0 = pm * GBM; u.col0 = pn * GBM; u.grp = grp; u.gslot = i;
    return true;
  }
};

struct EpiStoreF32 {
  float* C; int ldc; int ncols;
  __device__ __forceinline__ void operator()(const f32x4 (&acc)[2][2][4][2], const Unit& u, int wr, int wc, int fr, int fq) const {
#pragma unroll
    for (int ai = 0; ai < 2; ++ai)
#pragma unroll
      for (int m = 0; m < 4; ++m) {
        const int row = u.row0 + ai * GHALF + wr * 64 + m * 16 + fr;
#pragma unroll
        for (int bj = 0; bj < 2; ++bj)
#pragma unroll
          for (int n = 0; n < 2; ++n) {
            const int col = u.col0 + bj * GHALF + wc * 32 + n * 16 + fq * 4;
            if (col < ncols) *(f32x4*)(C + (size_t)row * ldc + col) = acc[ai][bj][m][n];
          }
      }
  }
};
struct EpiInproj {
  KP P; int ly;
  __device__ __forceinline__ void operator()(const f32x4 (&acc)[2][2][4][2], const Unit& u, int wr, int wc, int fr, int fq) const {
    bf16_t* Aq = P->Aq; bf16_t* Akv = P->Akv; bf16_t* Kr = P->Kr; float* huT = P->huT; bf16_t* zbuf = P->zbuf; bf16_t* xbcr = P->xbcr; float* dtv = P->dtv;
    float* ssq_q = P->ssq_q; float* ssq_kv = P->ssq_kv; const int* pos = P->pos; const float* dtb = P->ssm_dt_bias + ly * 8;
    const int rbase = u.row0 + wr * 64 + fr;
    float sq[2][4];
#pragma unroll
    for (int ai = 0; ai < 2; ++ai)
#pragma unroll
      for (int m = 0; m < 4; ++m) sq[ai][m] = 0.f;
#pragma unroll
    for (int bj = 0; bj < 2; ++bj)
#pragma unroll
      for (int n = 0; n < 2; ++n) {
        const int cbase = u.col0 + bj * GHALF + wc * 32 + n * 16;
        const int c = cbase + fq * 4;
        if (cbase < C_KR) {
          bf16_t* dst = (cbase < C_CKV) ? (Aq + c) : (Akv + (c - C_CKV));
          const int ld = (cbase < C_CKV) ? 256 : 128;
#pragma unroll
          for (int ai = 0; ai < 2; ++ai)
#pragma unroll
            for (int m = 0; m < 4; ++m) {
              const int row = rbase + ai * GHALF + m * 16;
              const f32x4 v = acc[ai][bj][m][n];
              u32x2 o = {pack2(v[0], v[1]), pack2(v[2], v[3])};
              *(u32x2*)(dst + (size_t)row * ld) = o;
              sq[ai][m] += v[0] * v[0] + v[1] * v[1] + v[2] * v[2] + v[3] * v[3];
            }
        } else if (cbase < C_HY) {
        } else if (cbase < C_Z) {
#pragma unroll
          for (int ai = 0; ai < 2; ++ai)
#pragma unroll
            for (int m = 0; m < 4; ++m) {
              const int row = rbase + ai * GHALF + m * 16;
              const int b = row / L, l = row % L;
              const f32x4 v = acc[ai][bj][m][n];
              float* hp = huT + ((size_t)b * 768 + (c - C_HY)) * L + l;
              hp[0] = v[0]; hp[L] = v[1]; hp[2 * (size_t)L] = v[2]; hp[3 * (size_t)L] = v[3];
            }
        } else if (cbase < C_XBC) {
#pragma unroll
          for (int ai = 0; ai < 2; ++ai)
#pragma unroll
            for (int m = 0; m < 4; ++m) {
              const int row = rbase + ai * GHALF + m * 16;
              { const f32x4 v = acc[ai][bj][m][n]; u32x2 o = {pack2(v[0], v[1]), pack2(v[2], v[3])}; *(u32x2*)(zbuf + (size_t)row * 256 + (c - C_Z)) = o; }
            }
        } else if (cbase < C_DT) {
#pragma unroll
          for (int ai = 0; ai < 2; ++ai)
#pragma unroll
            for (int m = 0; m < 4; ++m) {
              const int row = rbase + ai * GHALF + m * 16;
              { const f32x4 v = acc[ai][bj][m][n]; u32x2 o = {pack2(v[0], v[1]), pack2(v[2], v[3])}; *(u32x2*)(xbcr + (size_t)row * 768 + (c - C_XBC)) = o; }
            }
        } else if (cbase == C_DT) {
          if (fq < 2) {
            const f32x4 bb = *(const f32x4*)(dtb + fq * 4);
#pragma unroll
            for (int ai = 0; ai < 2; ++ai)
#pragma unroll
              for (int m = 0; m < 4; ++m) {
                const int row = rbase + ai * GHALF + m * 16;
                const f32x4 v = acc[ai][bj][m][n];
                f32x4 o;
#pragma unroll
                for (int e = 0; e < 4; ++e) { float t = v[e] + bb[e]; o[e] = (t > 20.f) ? t : __logf(1.f + __expf(t)); }
                *(f32x4*)(dtv + (size_t)row * 8 + fq * 4) = o;
              }
          }
        }
      }
    if (u.col0 == 0 || u.col0 == 256) {
      float* sp = (u.col0 == 0) ? ssq_q : ssq_kv;
#pragma unroll
      for (int ai = 0; ai < 2; ++ai)
#pragma unroll
        for (int m = 0; m < 4; ++m) {
          float t = sq[ai][m];
          t += __shfl_xor(t, 16); t += __shfl_xor(t, 32);
          if (fq == 0) sp[(size_t)(rbase + ai * GHALF + m * 16) * 4 + wc] = t;
        }
    }
    if (u.col0 == 256 && wc == 0) {
      int posq[2][4];
#pragma unroll
      for (int ai = 0; ai < 2; ++ai)
#pragma unroll
        for (int m = 0; m < 4; ++m) posq[ai][m] = pos[rbase + ai * GHALF + m * 16];
#pragma unroll 1
      for (int e = 0; e < 4; ++e) {
        const int j = fq * 4 + e;
#pragma unroll
        for (int ai = 0; ai < 2; ++ai)
#pragma unroll
          for (int m = 0; m < 4; ++m) {
            const int row = rbase + ai * GHALF + m * 16;
            float cs, sn;
            rope_cs(posq[ai][m], j, cs, sn);
            const f32x4 va = acc[ai][1][m][0], vb = acc[ai][1][m][1];
            const float k1 = (e == 0) ? va[0] : (e == 1) ? va[1] : (e == 2) ? va[2] : va[3];
            const float k2 = (e == 0) ? vb[0] : (e == 1) ? vb[1] : (e == 2) ? vb[2] : vb[3];
            Kr[(size_t)row * 32 + j] = f2bf(k1 * cs - k2 * sn);
            Kr[(size_t)row * 32 + 16 + j] = f2bf(k2 * cs + k1 * sn);
          }
      }
    }
  }
};
struct EpiStoreBf16 {
  bf16_t* C; int ldc;
  __device__ __forceinline__ void operator()(const f32x4 (&acc)[2][2][4][2], const Unit& u, int wr, int wc, int fr, int fq) const {
#pragma unroll
    for (int ai = 0; ai < 2; ++ai)
#pragma unroll
      for (int m = 0; m < 4; ++m) {
        const int row = u.row0 + ai * GHALF + wr * 64 + m * 16 + fr;
#pragma unroll
        for (int bj = 0; bj < 2; ++bj) {
          const int col = u.col0 + bj * GHALF + wc * 32 + fq * 8;
          const f32x4 a = acc[ai][bj][m][0], b = acc[ai][bj][m][1];
          u32x4 o = {pack2(a[0], a[1]), pack2(a[2], a[3]), pack2(b[0], b[1]), pack2(b[2], b[3])};
          *(u32x4*)(C + (size_t)row * ldc + col) = o;
        }
      }
  }
};
struct EpiResidF32 {
  float* X; const float* Xs;
  __device__ __forceinline__ void operator()(const f32x4 (&acc)[2][2][4][2], const Unit& u, int wr, int wc, int fr, int fq) const {
#pragma unroll
    for (int ai = 0; ai < 2; ++ai)
#pragma unroll
      for (int mh = 0; mh < 2; ++mh) {
        f32x4 xv[2][2][2];
#pragma unroll
        for (int mm = 0; mm < 2; ++mm)
#pragma unroll
          for (int bj = 0; bj < 2; ++bj)
#pragma unroll
            for (int n = 0; n < 2; ++n) {
              const int row = u.row0 + ai * GHALF + wr * 64 + (mh * 2 + mm) * 16 + fr;
              const int col = u.col0 + bj * GHALF + wc * 32 + n * 16 + fq * 4;
              xv[mm][bj][n] = *(const f32x4*)(Xs + (size_t)row * D + col);
            }
#pragma unroll
        for (int mm = 0; mm < 2; ++mm)
#pragma unroll
          for (int bj = 0; bj < 2; ++bj)
#pragma unroll
            for (int n = 0; n < 2; ++n) {
              const int row = u.row0 + ai * GHALF + wr * 64 + (mh * 2 + mm) * 16 + fr;
              const int col = u.col0 + bj * GHALF + wc * 32 + n * 16 + fq * 4;
              *(f32x4*)(X + (size_t)row * D + col) = xv[mm][bj][n] + acc[ai][bj][mh * 2 + mm][n];
            }
      }
  }
};
struct EpiPleF32 {
  float* X; const bf16_t* PP;
  __device__ __forceinline__ void operator()(const f32x4 (&acc)[2][2][4][2], const Unit& u, int wr, int wc, int fr, int fq) const {
#pragma unroll
    for (int ai = 0; ai < 2; ++ai)
#pragma unroll
      for (int mh = 0; mh < 2; ++mh) {
        f32x4 xv[2][2][2];
        u32x2 pq[2][2][2];
#pragma unroll
        for (int mm = 0; mm < 2; ++mm)
#pragma unroll
          for (int bj = 0; bj < 2; ++bj)
#pragma unroll
            for (int n = 0; n < 2; ++n) {
              const int row = u.row0 + ai * GHALF + wr * 64 + (mh * 2 + mm) * 16 + fr;
              const int col = u.col0 + bj * GHALF + wc * 32 + n * 16 + fq * 4;
              const size_t o = (size_t)row * D + col;
              pq[mm][bj][n] = *(const u32x2*)(PP + o);
              xv[mm][bj][n] = *(const f32x4*)(X + o);
            }
#pragma unroll
        for (int mm = 0; mm < 2; ++mm)
#pragma unroll
          for (int bj = 0; bj < 2; ++bj)
#pragma unroll
            for (int n = 0; n < 2; ++n) {
              const int row = u.row0 + ai * GHALF + wr * 64 + (mh * 2 + mm) * 16 + fr;
              const int col = u.col0 + bj * GHALF + wc * 32 + n * 16 + fq * 4;
              const f32x4 pp = unpack4(pq[mm][bj][n]);
              const f32x4 a = acc[ai][bj][mh * 2 + mm][n];
              f32x4 r = xv[mm][bj][n];
#pragma unroll
              for (int j = 0; j < 4; ++j) r[j] += pp[j] * sigmf(a[j]);
              *(f32x4*)(X + (size_t)row * D + col) = r;
            }
      }
  }
};
struct EpiSwigluBf16 {
  bf16_t* H;
  __device__ __forceinline__ void operator()(const f32x4 (&acc)[2][2][4][2], const Unit& u, int wr, int wc, int fr, int fq) const {
    bf16_t* Hg = H + (size_t)u.grp * CAP * FF;
    const int hcol = (u.col0 >> 1) + wc * 32 + fq * 8;
#pragma unroll
    for (int ai = 0; ai < 2; ++ai)
#pragma unroll
      for (int m = 0; m < 4; ++m) {
        const int row = u.row0 + ai * GHALF + wr * 64 + m * 16 + fr;
        const f32x4 g0 = acc[ai][0][m][0], g1 = acc[ai][0][m][1], u0 = acc[ai][1][m][0], u1 = acc[ai][1][m][1];
        u32x4 o = {pack2(siluf(g0[0]) * u0[0], siluf(g0[1]) * u0[1]), pack2(siluf(g0[2]) * u0[2], siluf(g0[3]) * u0[3]),
                   pack2(siluf(g1[0]) * u1[0], siluf(g1[1]) * u1[1]), pack2(siluf(g1[2]) * u1[2], siluf(g1[3]) * u1[3])};
        *(u32x4*)(Hg + (size_t)row * FF + hcol) = o;
      }
  }
};
struct EpiMoeDownY {
  bf16_t* Y; const float* gs;
  __device__ __forceinline__ void operator()(const f32x4 (&acc)[2][2][4][2], const Unit& u, int wr, int wc, int fr, int fq) const {
    bf16_t* Yg = Y + (size_t)u.grp * CAP * D;
    const float* gg = gs + u.grp * CAP;
    float gq[2][4];
#pragma unroll
    for (int ai = 0; ai < 2; ++ai)
#pragma unroll
      for (int m = 0; m < 4; ++m) gq[ai][m] = gg[u.row0 + ai * GHALF + wr * 64 + m * 16 + fr];
#pragma unroll
    for (int ai = 0; ai < 2; ++ai)
#pragma unroll
      for (int m = 0; m < 4; ++m) {
        const int row = u.row0 + ai * GHALF + wr * 64 + m * 16 + fr;
        const float g = gq[ai][m];
#pragma unroll
        for (int bj = 0; bj < 2; ++bj) {
          const int col = u.col0 + bj * GHALF + wc * 32 + fq * 8;
          const f32x4 a = acc[ai][bj][m][0], b = acc[ai][bj][m][1];
          u32x4 o = {pack2(g * a[0], g * a[1]), pack2(g * a[2], g * a[3]), pack2(g * b[0], g * b[1]), pack2(g * b[2], g * b[3])};
          *(u32x4*)(Yg + (size_t)row * D + col) = o;
        }
      }
  }
};
}

template <int NC>
__device__ __forceinline__ void rms_row_bf16(const float* xr, const float* __restrict__ g, bf16_t* yr, int lane) {
  constexpr int IT = (NC + 255) / 256;
  float4 v[IT];
  float ss = 0.f;
#pragma unroll
  for (int i = 0; i < IT; ++i) {
    int c = i * 256 + lane * 4;
    if (c < NC) {
      v[i] = *(const float4*)(xr + c);
      ss += v[i].x * v[i].x + v[i].y * v[i].y + v[i].z * v[i].z + v[i].w * v[i].w;
    }
  }
  ss = wave_sum(ss);
  float rs = rsqrtf(ss * (1.f / NC) + EPS);
#pragma unroll
  for (int i = 0; i < IT; ++i) {
    int c = i * 256 + lane * 4;
    if (c < NC) {
      float4 g4 = *(const float4*)(g + c);
      uint2 o;
      o.x = pack2(v[i].x * rs * g4.x, v[i].y * rs * g4.y);
      o.y = pack2(v[i].z * rs * g4.z, v[i].w * rs * g4.w);
      *(uint2*)(yr + c) = o;
    }
  }
}

__device__ __forceinline__ void phase_convert_gu(KP P, int ly, char* sm) {
  convert_T2(P->w_gate + (size_t)ly * NE * D * FF, P->Wgu_t, D, FF, FF, NE, (size_t)D * FF, (size_t)2 * FF * D, 1, sm, nullptr, 32, 224);
  convert_T2(P->w_up + (size_t)ly * NE * D * FF, P->Wgu_t, D, FF, FF, NE, (size_t)D * FF, (size_t)2 * FF * D, 2, sm);
}
__device__ __forceinline__ void phase_convert(KP P, int ly, float* tile) {
  LAUNDER_IDS
  const bool wide = GDIM >= 244;
  convert_T2(P->w_in + (size_t)ly * D * NIN, P->Win_t, D, NIN, NINP, 1, 0, 0, 0, (char*)tile);
  convert_T2(P->w_out + (size_t)ly * D * D, P->Wout_t, D, D, D, 1, 0, 0, 0, (char*)tile, nullptr, wide ? 144 : 0, wide ? 64 : 0);
  convert_T2(P->w_uq + (size_t)ly * 256 * 768, P->Wuq_t, 256, 768, 768, 1, 0, 0, 0, (char*)tile, P->q_norm + ly * 256, wide ? 208 : 0, wide ? 12 : 0);
  convert_T2(P->w_ukv + (size_t)ly * 128 * 1024, P->Wukv_t, 128, 1024, 1024, 1, 0, 0, 0, (char*)tile, P->kv_norm + ly * 128, wide ? 220 : 0, wide ? 8 : 0);
  convert_T2(P->ple_proj + (size_t)ly * 256 * D, P->Wpp_t, 256, D, D, 1, 0, 0, 4, (char*)tile, nullptr, wide ? 228 : 0, wide ? 16 : 0);
}

__device__ __forceinline__ void phase_convert_down(KP P, int ly, char* sm) {
  LAUNDER_IDS
  const int v0 = (GDIM > 64) ? 64 : 0;
  convert_T2(P->ple_gate_w + (size_t)ly * D * D, P->Wpg_t, D, D, D, 1, 0, 0, 0, sm, nullptr, v0, GDIM - v0);
  convert_T2(P->w_down + (size_t)ly * NE * FF * D, P->Wd_t, FF, D, D, 8, (size_t)FF * D, (size_t)D * FF, 4, sm, nullptr, v0, GDIM - v0);
  convert_T2(P->w_down + (size_t)ly * NE * FF * D + (size_t)8 * FF * D, P->Wd_t + (size_t)8 * D * FF, FF, D, D, 8, (size_t)FF * D, (size_t)D * FF, 4, sm);
}
__device__ __forceinline__ void phase_filters(KP P, int ly, float* sm, int vb0) {
  LAUNDER_IDS
  const int VB = BIDX - vb0, VG = GDIM - vb0;
  float* h1 = sm;
  float* h2 = sm + 64 * 65;
  float* sw2 = h2 + 64 * 65;
  float* sw1 = sw2 + 64 * 64;
  float* wsl = sw1 + 17 * 64;
  const float* w1 = P->hy_w1 + ly * 17 * 64;
  const float* b1 = P->hy_b1 + ly * 64;
  const float* fr = P->hy_freq + ly * 64;
  const float* w2 = P->hy_w2 + ly * 64 * 64;
  const float* b2 = P->hy_b2 + ly * 64;
  const float* w3 = P->hy_w3 + (size_t)ly * 64 * 1024;
  const float* dec = P->hy_decay + ly * 1024;
  const int tid = TIDX, lane = tid & 63, wid = tid >> 6;
  if (VB < 0 || VB >= L / 64) return;
  __syncthreads();
  for (int i = tid; i < 64 * 64; i += NTHREADS) sw2[i] = w2[i];
  for (int i = tid; i < 17 * 64; i += NTHREADS) sw1[i] = w1[i];
  for (int tb = VB; tb < L / 64; tb += VG) {
    const int tl = lane, jg = wid;
    float tt = (float)(tb * 64 + tl) / (float)L;
    __syncthreads();
    {
      float feats[17];
      feats[0] = tt;
#pragma unroll
      for (int b = 0; b < 8; ++b) {
        float rev = tt * (float)(b + 1);
        feats[1 + b] = __builtin_amdgcn_sinf(rev);
        feats[9 + b] = __builtin_amdgcn_cosf(rev);
      }
#pragma unroll
      for (int jj = 0; jj < 8; ++jj) {
        int j = jg * 8 + jj;
        float a = b1[j];
#pragma unroll
        for (int f = 0; f < 17; ++f) a += feats[f] * sw1[f * 64 + j];
        h1[tl * 65 + j] = __sinf(fr[j] * a);
      }
    }
    __syncthreads();
    {
      float a[8];
#pragma unroll
      for (int jj = 0; jj < 8; ++jj) a[jj] = b2[jg * 8 + jj];
      for (int k = 0; k < 64; ++k) {
        float hv = h1[tl * 65 + k];
        f32x4 wa = *(const f32x4*)(sw2 + k * 64 + jg * 8), wb = *(const f32x4*)(sw2 + k * 64 + jg * 8 + 4);
        a[0] += hv * wa[0]; a[1] += hv * wa[1]; a[2] += hv * wa[2]; a[3] += hv * wa[3];
        a[4] += hv * wb[0]; a[5] += hv * wb[1]; a[6] += hv * wb[2]; a[7] += hv * wb[3];
      }
#pragma unroll
      for (int jj = 0; jj < 8; ++jj) h2[tl * 65 + jg * 8 + jj] = __sinf(fr[jg * 8 + jj] * a[jj]);
    }
    __syncthreads();
    float* wb_ = wsl + wid * 512;
#pragma unroll 1
    for (int c0 = jg * 128; c0 < jg * 128 + 128; c0 += 8) {
      {
        f32x4 x0 = *(const f32x4*)(w3 + (size_t)lane * 1024 + c0), x1 = *(const f32x4*)(w3 + (size_t)lane * 1024 + c0 + 4);
        *(f32x4*)(wb_ + lane * 8) = x0; *(f32x4*)(wb_ + lane * 8 + 4) = x1;
      }
      float a[8];
#pragma unroll
      for (int jj = 0; jj < 8; ++jj) a[jj] = 0.f;
      for (int k = 0; k < 64; ++k) {
        float hv = h2[tl * 65 + k];
        f32x4 wa = *(const f32x4*)(wb_ + k * 8), wb2 = *(const f32x4*)(wb_ + k * 8 + 4);
        a[0] += hv * wa[0]; a[1] += hv * wa[1]; a[2] += hv * wa[2]; a[3] += hv * wa[3];
        a[4] += hv * wb2[0]; a[5] += hv * wb2[1]; a[6] += hv * wb2[2]; a[7] += hv * wb2[3];
      }
#pragma unroll
      for (int jj = 0; jj < 8; ++jj) {
        float win = __expf(-tt * fabsf(dec[c0 + jj]));
        P->filtT[(size_t)(c0 + jj) * L + tb * 64 + tl] = (_Float16)(a[jj] * win);
      }
    }
  }
}

__device__ __forceinline__ void phase_copy_x(KP P) {
  LAUNDER_IDS
  const float4* s = (const float4*)P->x;
  float4* d = (float4*)P->xcur;
  const int n = T * D / 4;
  for (int i = BIDX * NTHREADS + TIDX; i < n; i += GDIM * NTHREADS) d[i] = s[i];
}

__device__ __forceinline__ void phase_rms_x(KP P, const float* xsrc, const float* g, bf16_t* dst) {
  LAUNDER_IDS
  const int lane = TIDX & 63;
  const int gw = BIDX * 8 + (TIDX >> 6), nw = GDIM * 8;
  if (gw >= T) return;
  f32x4 cur[4], nx[4], gv[4];
#pragma unroll
  for (int i = 0; i < 4; ++i) { cur[i] = *(const f32x4*)(xsrc + (size_t)gw * D + i * 256 + lane * 4); gv[i] = *(const f32x4*)(g + i * 256 + lane * 4); }
  for (int row = gw; row < T; row += nw) {
    const int nr = (row + nw < T) ? (row + nw) : row;
#pragma unroll
    for (int i = 0; i < 4; ++i) nx[i] = *(const f32x4*)(xsrc + (size_t)nr * D + i * 256 + lane * 4);
    float ss = 0.f;
#pragma unroll
    for (int i = 0; i < 4; ++i) ss += cur[i][0] * cur[i][0] + cur[i][1] * cur[i][1] + cur[i][2] * cur[i][2] + cur[i][3] * cur[i][3];
    ss = wave_sum(ss);
    const float rs = rsqrtf(ss * (1.f / D) + EPS);
#pragma unroll
    for (int i = 0; i < 4; ++i) {
      const int c = i * 256 + lane * 4;
      const f32x4 g4 = gv[i];
      u32x2 o = {pack2(cur[i][0] * rs * g4[0], cur[i][1] * rs * g4[1]), pack2(cur[i][2] * rs * g4[2], cur[i][3] * rs * g4[3])};
      *(u32x2*)(dst + (size_t)row * D + c) = o;
    }
#pragma unroll
    for (int i = 0; i < 4; ++i) cur[i] = nx[i];
  }
}

struct EpiStore {
  float* C; int ldc; int N; int row0; int col0;
  __device__ __forceinline__ void operator()(f32x4 (&acc)[4][4], int rb, int cb) const {
#pragma unroll
    for (int m = 0; m < 4; ++m)
#pragma unroll
      for (int n = 0; n < 4; ++n)
#pragma unroll
        for (int j = 0; j < 4; ++j) {
          int row = row0 + rb + m * 16 + j, col = col0 + cb + n * 16;
          if (col < N) C[(size_t)row * ldc + col] = acc[m][n][j];
        }
  }
};
struct EpiResid {
  float* X; int row0; int col0;
  __device__ __forceinline__ void operator()(f32x4 (&acc)[4][4], int rb, int cb) const {
#pragma unroll
    for (int m = 0; m < 4; ++m)
#pragma unroll
      for (int n = 0; n < 4; ++n)
#pragma unroll
        for (int j = 0; j < 4; ++j) {
          int row = row0 + rb + m * 16 + j, col = col0 + cb + n * 16;
          X[(size_t)row * D + col] += acc[m][n][j];
        }
  }
};
struct EpiPle {
  float* X; const float* PP; int row0; int col0;
  __device__ __forceinline__ void operator()(f32x4 (&acc)[4][4], int rb, int cb) const {
#pragma unroll
    for (int m = 0; m < 4; ++m)
#pragma unroll
      for (int n = 0; n < 4; ++n)
#pragma unroll
        for (int j = 0; j < 4; ++j) {
          int row = row0 + rb + m * 16 + j, col = col0 + cb + n * 16;
          size_t o = (size_t)row * D + col;
          float gte = 1.f / (1.f + __expf(-acc[m][n][j]));
          X[o] += PP[o] * gte;
        }
  }
};
struct EpiSwiglu {
  bf16_t* H; int row0; int hcol0;
  __device__ __forceinline__ void operator()(f32x4 (&acc)[4][4], int rb, int cb) const {
    int wc64 = cb & 64, fr = cb & 15;
#pragma unroll
    for (int m = 0; m < 4; ++m)
#pragma unroll
      for (int n = 0; n < 2; ++n)
#pragma unroll
        for (int j = 0; j < 4; ++j) {
          int row = row0 + rb + m * 16 + j;
          int col = hcol0 + (wc64 >> 1) + n * 16 + fr;
          float a = acc[m][n][j], u = acc[m][n + 2][j];
          H[(size_t)row * FF + col] = f2bf(siluf(a) * u);
        }
  }
};
struct EpiMoeDown {
  float* Xb; const int* idx; const float* gs; int row0; int col0;
  __device__ __forceinline__ void operator()(f32x4 (&acc)[4][4], int rb, int cb) const {
#pragma unroll
    for (int m = 0; m < 4; ++m)
#pragma unroll
      for (int j = 0; j < 4; ++j) {
        int row = row0 + rb + m * 16 + j;
        int tok = idx[row];
        float g = gs[row];
#pragma unroll
        for (int n = 0; n < 4; ++n) {
          int col = col0 + cb + n * 16;
          unsafeAtomicAdd(&Xb[(size_t)tok * D + col], g * acc[m][n][j]);
        }
      }
  }
};

struct EpiQ {
  bf16_t* Qb; const float* ssq; const int* pos; int row0; int col0;
  __device__ __forceinline__ void operator()(f32x4 (&acc)[4][6], int rb, int cb) const {
    const float qs = 0.14724445f;
    const int fq4 = cb & 15, wcb = cb - fq4;
    const int h = (col0 + wcb) / 96;
#pragma unroll
    for (int m = 0; m < 4; ++m) {
      const int row = row0 + rb + m * 16;
      const int b = row / L, l = row % L;
      const f32x4 sp4 = *(const f32x4*)(ssq + (size_t)row * 4);
      const float rs = rsqrtf(((sp4[0] + sp4[1]) + (sp4[2] + sp4[3])) * (1.f / 256.f) + EPS) * qs;
      bf16_t* Q = Qb + (((size_t)(b * 8 + h)) * L + l) * 96 + fq4;
#pragma unroll
      for (int n = 0; n < 4; ++n) {
        const f32x4 v = acc[m][n];
        u32x2 o = {pack2(v[0] * rs, v[1] * rs), pack2(v[2] * rs, v[3] * rs)};
        *(u32x2*)(Q + n * 16) = o;
      }
      const int pp = pos[row];
      float o1[4], o2[4];
#pragma unroll
      for (int j = 0; j < 4; ++j) {
        float cs, sn;
        rope_cs(pp, fq4 + j, cs, sn);
        const float t1 = acc[m][4][j] * rs, t2 = acc[m][5][j] * rs;
        o1[j] = t1 * cs - t2 * sn;
        o2[j] = t2 * cs + t1 * sn;
      }
      u32x2 w1 = {pack2(o1[0], o1[1]), pack2(o1[2], o1[3])};
      u32x2 w2 = {pack2(o2[0], o2[1]), pack2(o2[2], o2[3])};
      *(u32x2*)(Q + 64) = w1;
      *(u32x2*)(Q + 80) = w2;
    }
  }
};
struct EpiKV {
  bf16_t* Kn; bf16_t* Vt; const float* ssq; int row0; int col0;
  __device__ __forceinline__ void t(f32x4 (&acc)[4][4], int rb, int fq4) const {
    const int h = col0 >> 7;
    f32x4 spq[4];
#pragma unroll
    for (int m = 0; m < 4; ++m) spq[m] = *(const f32x4*)(ssq + (size_t)(row0 + rb + m * 16) * 4);
#pragma unroll
    for (int m = 0; m < 4; ++m) {
      const int row = row0 + rb + m * 16;
      const int b = row / L, lb = row % L;
      const f32x4 sp4 = spq[m];
      const float rs = rsqrtf(((sp4[0] + sp4[1]) + (sp4[2] + sp4[3])) * (1.f / 128.f) + EPS);
      bf16_t* kp = Kn + (((size_t)(b * 8 + h)) * L + lb) * 64 + fq4;
#pragma unroll
      for (int n = 0; n < 4; ++n) {
        const f32x4 v = acc[m][n];
        u32x2 o = {pack2(v[0] * rs, v[1] * rs), pack2(v[2] * rs, v[3] * rs)};
        *(u32x2*)(kp + n * 16) = o;
      }
    }
  }
  __device__ __forceinline__ void operator()(f32x4 (&acc)[4][4], int rb, int cb) const {
    const int fr = cb & 15, wcb = cb - fr;
    float rsq[4][4];
#pragma unroll
    for (int m = 0; m < 4; ++m)
#pragma unroll
      for (int j = 0; j < 4; ++j) { const f32x4 sp4 = *(const f32x4*)(ssq + (size_t)(row0 + rb + m * 16 + j) * 4); rsq[m][j] = rsqrtf(((sp4[0] + sp4[1]) + (sp4[2] + sp4[3])) * (1.f / 128.f) + EPS); }
#pragma unroll
    for (int m = 0; m < 4; ++m) {
      const int rowb = row0 + rb + m * 16;
      const int b = rowb / L, lb = rowb % L;
      float rs[4];
#pragma unroll
      for (int j = 0; j < 4; ++j) rs[j] = rsq[m][j];
#pragma unroll
      for (int n = 0; n < 4; ++n) {
        const int c0 = col0 + wcb + n * 16;
        const int h = c0 >> 7, cc0 = c0 & 127;
        if (cc0 < 64) {
#pragma unroll
          for (int j = 0; j < 4; ++j) Kn[(((size_t)(b * 8 + h)) * L + lb + j) * 64 + cc0 + fr] = f2bf(acc[m][n][j] * rs[j]);
        } else {
          u32x2 o = {pack2(acc[m][n][0] * rs[0], acc[m][n][1] * rs[1]), pack2(acc[m][n][2] * rs[2], acc[m][n][3] * rs[3])};
          const int lbp = (lb & ~12) | ((lb & 4) << 1) | ((lb & 8) >> 1);
          *(u32x2*)(Vt + (((size_t)(b * 8 + h)) * 64 + (cc0 - 64 + fr)) * L + lbp) = o;
        }
      }
    }
  }
};
__device__ __forceinline__ void phase_gemm_inproj(KP P, char* smem) {
  LAUNDER_IDS
  constexpr int NT = NINP / BN;
  for (int t = BIDX; t < (T / BM) * NT; t += GDIM) {
    int mi = t / NT, ni = t % NT;
    EpiStore e{P->proj, NIN, NIN, mi * BM, ni * BN};
    gemm_tile(P->A1 + (size_t)mi * BM * D, D, nullptr, P->Win_t + (size_t)ni * BN * D, D, D, smem, e);
  }
}
__device__ __forceinline__ void phase_gemm_qkv(KP P, char* smem) {
  LAUNDER_IDS
  constexpr int NTQ = 768 / 192, NTK = 1024 / BN;
  constexpr int TQ = (T / BM) * NTQ, TK = (T / BM) * NTK;
  for (int t = BIDX; t < TQ + TK; t += GDIM) {
    if (t < TQ) {
      int mi = t / NTQ, ni = t % NTQ;
      EpiQ e{P->Qb, P->ssq_q, P->pos, mi * BM, ni * 192};
      gemm_tile<1, 6>(P->Aq + (size_t)mi * BM * 256, 256, nullptr, P->Wuq_t + (size_t)ni * 192 * 256, 256, 256, smem, e);
    } else {
      int u = t - TQ;
      int mi = u / NTK, ni = u % NTK;
      EpiKV e{P->Kn, P->Vt, P->ssq_kv, mi * BM, ni * BN};
      gemm_tile<2>(P->Akv + (size_t)mi * BM * 128, 128, nullptr, P->Wukv_t + (size_t)ni * BN * 128, 128, 128, smem, e);
    }
  }
}
__device__ __forceinline__ void phase_gemm_out(KP P, char* smem) {
  LAUNDER_IDS
  constexpr int NT = D / BN;
  for (int t = BIDX; t < (T / BM) * NT; t += GDIM) {
    int mi = t / NT, ni = t % NT;
    EpiResid e{P->xcur, mi * BM, ni * BN};
    gemm_tile(P->A1 + (size_t)mi * BM * D, D, nullptr, P->Wout_t + (size_t)ni * BN * D, D, D, smem, e);
  }
}
__device__ __forceinline__ void phase_gemm_pp(KP P, char* smem) {
  LAUNDER_IDS
  constexpr int NT = D / BN;
  for (int t = BIDX; t < (T / BM) * NT; t += GDIM) {
    int mi = t / NT, ni = t % NT;
    EpiStore e{P->PP, D, D, mi * BM, ni * BN};
    gemm_tile(P->Ap + (size_t)mi * BM * 256, 256, nullptr, P->Wpp_t + (size_t)ni * BN * 256, 256, 256, smem, e);
  }
}
__device__ __forceinline__ void phase_gemm_ple(KP P, char* smem) {
  LAUNDER_IDS
  constexpr int NT = D / BN;
  for (int t = BIDX; t < (T / BM) * NT; t += GDIM) {
    int mi = t / NT, ni = t % NT;
    EpiPle e{P->xcur, P->PP, mi * BM, ni * BN};
    gemm_tile(P->A1 + (size_t)mi * BM * D, D, nullptr, P->Wpg_t + (size_t)ni * BN * D, D, D, smem, e);
  }
}
__device__ __forceinline__ void phase_moe1(KP P, char* smem) {
  LAUNDER_IDS
  for (int t = BIDX; t < 16 * 32 * 2 * 4; t += GDIM) {
    int mt = t & 3, b = (t >> 2) & 1, ni = (t >> 3) & 31, e = t >> 8;
    int g = b * NE + e;
    EpiSwiglu ep{P->H + (size_t)g * CAP * FF, mt * BM, ni * (BN / 2)};
    gemm_tile(P->A1 + (size_t)b * L * D, D, P->idx + g * CAP + mt * BM, P->Wgu_t + ((size_t)e * 2 * FF + ni * BN) * D, D, D, smem, ep);
  }
}
__device__ __forceinline__ void phase_moe2(KP P, char* smem) {
  LAUNDER_IDS
  for (int t = BIDX; t < 16 * 8 * 2 * 4; t += GDIM) {
    int mt = t & 3, b = (t >> 2) & 1, ni = (t >> 3) & 7, e = t >> 6;
    int g = b * NE + e;
    EpiMoeDown ep{P->xcur + (size_t)b * L * D, P->idx + g * CAP, P->gsel + g * CAP, mt * BM, ni * BN};
    gemm_tile(P->H + ((size_t)g * CAP + mt * BM) * FF, FF, nullptr, P->Wd_t + ((size_t)e * D + ni * BN) * FF, FF, FF, smem, ep);
  }
}

__device__ __forceinline__ void phase_g8_inproj(KP P, int ly, char* smem) {
  LAUNDER_IDS
  __syncthreads();
  g8::DenseSched S{(const char*)P->A1, (const char*)P->Win_t, D, D, T / 256, NINP / 256, (T / 256) * (NINP / 256), GDIM, BIDX};
  g8::EpiInproj E{P, ly};
  g8::gemm_phase<false>((G8_LAS unsigned char*)smem, D, D, D, S, E, TIDX);
}
__device__ __forceinline__ void phase_g8_out(KP P, int ly, char* smem) {
  LAUNDER_IDS
  __syncthreads();
  g8::DenseSched S{(const char*)P->A1, (const char*)P->Wout_t, D, D, T / 256, D / 256, (T / 256) * (D / 256), GDIM, BIDX};
  g8::EpiResidF32 E{P->xcur, (ly == 0) ? P->x : P->xcur};
  g8::gemm_phase<false>((G8_LAS unsigned char*)smem, D, D, D, S, E, TIDX);
}
__device__ __forceinline__ void phase_g8_pp(KP P, char* smem) {
  LAUNDER_IDS
  __syncthreads();
  g8::DenseSched S{(const char*)P->Ap, (const char*)P->Wpp_t, 256, 256, T / 256, D / 256, (T / 256) * (D / 256), GDIM, BIDX};
  g8::EpiStoreBf16 E{P->PPb, D};
  g8::gemm_phase<false>((G8_LAS unsigned char*)smem, 256, 256, 256, S, E, TIDX);
}
__device__ __forceinline__ void phase_g8_ple(KP P, char* smem) {
  LAUNDER_IDS
  __syncthreads();
  g8::DenseSched S{(const char*)P->A1, (const char*)P->Wpg_t, D, D, T / 256, D / 256, (T / 256) * (D / 256), GDIM, BIDX};
  g8::EpiPleF32 E{P->xcur, P->PPb};
  g8::gemm_phase<false>((G8_LAS unsigned char*)smem, D, D, D, S, E, TIDX);
}
__device__ __forceinline__ void phase_g8_moe1(KP P, char* smem) {
  LAUNDER_IDS
  __syncthreads();
  g8::MoeSched S{(const char*)P->A1, (const char*)P->Wgu_t, D, D, 16, 8, GDIM, BIDX, 0, (size_t)2 * FF * D * 2, true};
  {
    int* gl = (int*)(smem + g8::STAGE_BYTES);
    g8::Unit u;
    for (int i = 0; i < 8; ++i) {
      if (!S.next(i, u)) break;
      if (TIDX < 256) gl[i * 256 + TIDX] = P->idx[u.grp * CAP + u.row0 + TIDX];
    }
    __syncthreads();
  }
  g8::EpiSwigluBf16 E{P->H};
  g8::gemm_phase<true>((G8_LAS unsigned char*)smem, D, D, D, S, E, TIDX);
}
__device__ __forceinline__ void phase_g8_moe2(KP P, char* smem) {
  LAUNDER_IDS
  __syncthreads();
  g8::MoeSched S{(const char*)P->H, (const char*)P->Wd_t, FF, FF, 4, 2, GDIM, BIDX, (size_t)CAP * FF * 2, (size_t)D * FF * 2, false};
  g8::EpiMoeDownY E{P->Ybuf, P->gsel};
  g8::gemm_phase<false>((G8_LAS unsigned char*)smem, FF, FF, FF, S, E, TIDX);
}

__device__ __forceinline__ void phase_prep2(KP P, int ly, float* sm) {
  LAUNDER_IDS
  const float* cw = P->ssm_conv_w + ly * 5 * 768;
  const float* cb = P->ssm_conv_b + ly * 768;
  for (int i = BIDX * NTHREADS + TIDX; i < T * 192; i += GDIM * NTHREADS) {
    const int row = i / 192, c = (i % 192) * 4;
    const int l = row & (L - 1);
    f32x4 a = *(const f32x4*)(cb + c);
#pragma unroll
    for (int k = 0; k < 5; ++k) {
      const int ll = l + k - 2;
      if (ll >= 0 && ll < L) {
        f32x4 w = *(const f32x4*)(cw + k * 768 + c);
        f32x4 x = unpack4(*(const u32x2*)(P->xbcr + (size_t)(row + k - 2) * 768 + c));
        a += w * x;
      }
    }
    f32x4 o = {siluf(a[0]), siluf(a[1]), siluf(a[2]), siluf(a[3])};
    *(f32x4*)(P->xbc + (size_t)row * 768 + c) = o;
  }
}

__device__ __forceinline__ void hyena_conv_item(const float* vin, const float* kf, const float* kb, float bias, const float* gate, float* outp,
                                int t0, float* sm) {
  LAUNDER_IDS
  float* vs = sm;
  float* kw = sm + 512;
  const int tid = TIDX;
  float acc = 0.f;
  for (int s0 = 0; s0 < L; s0 += 512) {
    __syncthreads();
    vs[tid] = vin[s0 + tid];
    for (int i = tid; i < 1023; i += NTHREADS) {
      int d = t0 - s0 - 511 + i;
      kw[i] = (d >= 0) ? kf[d] : kb[-d];
    }
    __syncthreads();
#pragma unroll 4
    for (int j = 0; j < 512; j += 4) {
      float4 v4 = *(const float4*)(vs + j);
      int base = tid + 511 - j;
      acc += kw[base] * v4.x + kw[base - 1] * v4.y + kw[base - 2] * v4.z + kw[base - 3] * v4.w;
    }
  }
  int t = t0 + tid;
  outp[t] = (acc + bias * vin[t]) * gate[t];
}
__device__ __forceinline__ void phase_hyena_conv(KP P, int ly, int order, float* sm) {
  LAUNDER_IDS
  for (int it = BIDX; it < NB * 256 * 16; it += GDIM) {
    int tb = it & 15, c = (it >> 4) & 255, b = it >> 12;
    const float* vin = (order == 0) ? (P->huT + ((size_t)b * 768 + 512 + c) * L) : (P->v1T + ((size_t)b * 256 + c) * L);
    const float* kf = (const float*)P->filtT + (size_t)(order * 512 + c) * L;
    const float* kb = (const float*)P->filtT + (size_t)(order * 512 + 256 + c) * L;
    float bias = P->hy_bias[ly * 512 + order * 256 + c];
    const float* gate = P->huT + ((size_t)b * 768 + order * 256 + c) * L;
    float* outp = (order == 0) ? (P->v1T + ((size_t)b * 256 + c) * L) : (P->ohyT + ((size_t)b * 256 + c) * L);
    hyena_conv_item(vin, kf, kb, bias, gate, outp, tb * 512, sm);
  }
}

constexpr int FFT_N = 16384;
constexpr int FFT_LDS_BYTES = (FFT_N + FFT_N / 16) * 8;
__device__ __forceinline__ int PH(int i) { return i + (i >> 4); }

__device__ __forceinline__ void dif16(float (&xr)[16], float (&xi)[16]) {
  constexpr float C16[8] = {1.f, 0.9238795325112867f, 0.7071067811865476f, 0.3826834323650898f, 0.f, -0.3826834323650898f, -0.7071067811865476f, -0.9238795325112867f};
  constexpr float S16[8] = {0.f, 0.3826834323650898f, 0.7071067811865476f, 0.9238795325112867f, 1.f, 0.9238795325112867f, 0.7071067811865476f, 0.3826834323650898f};
#pragma unroll
  for (int half = 8; half >= 1; half >>= 1) {
#pragma unroll
    for (int g = 0; g < 16; g += 2 * half) {
#pragma unroll
      for (int j = 0; j < half; ++j) {
        const int k = j * (8 / half);
        const float c = C16[k], sn = S16[k];
        float ar = xr[g + j], ai = xi[g + j], br = xr[g + j + half], bi = xi[g + j + half];
        xr[g + j] = ar + br; xi[g + j] = ai + bi;
        float dr = ar - br, di = ai - bi;
        xr[g + j + half] = dr * c + di * sn;
        xi[g + j + half] = di * c - dr * sn;
      }
    }
  }
}
__device__ __forceinline__ void dit16(float (&xr)[16], float (&xi)[16]) {
  constexpr float C16[8] = {1.f, 0.9238795325112867f, 0.7071067811865476f, 0.3826834323650898f, 0.f, -0.3826834323650898f, -0.7071067811865476f, -0.9238795325112867f};
  constexpr float S16[8] = {0.f, 0.3826834323650898f, 0.7071067811865476f, 0.9238795325112867f, 1.f, 0.9238795325112867f, 0.7071067811865476f, 0.3826834323650898f};
#pragma unroll
  for (int half = 1; half <= 8; half <<= 1) {
#pragma unroll
    for (int g = 0; g < 16; g += 2 * half) {
#pragma unroll
      for (int j = 0; j < half; ++j) {
        const int k = j * (8 / half);
        const float c = C16[k], sn = S16[k];
        float ar = xr[g + j], ai = xi[g + j], br0 = xr[g + j + half], bi0 = xi[g + j + half];
        float br = br0 * c - bi0 * sn;
        float bi = bi0 * c + br0 * sn;
        xr[g + j] = ar + br; xi[g + j] = ai + bi;
        xr[g + j + half] = ar - br; xi[g + j + half] = ai - bi;
      }
    }
  }
}
__device__ __forceinline__ void twiddle16(float (&xr)[16], float (&xi)[16], float er, float ei) {
  constexpr int BR4[16] = {0, 8, 4, 12, 2, 10, 6, 14, 1, 9, 5, 13, 3, 11, 7, 15};
  float pr = er, pi = ei;
#pragma unroll
  for (int q = 1; q < 16; ++q) {
    const int mp = BR4[q];
    float tr = xr[mp] * pr - xi[mp] * pi;
    float ti = xr[mp] * pi + xi[mp] * pr;
    xr[mp] = tr; xi[mp] = ti;
    if (q < 15) {
      float nr = pr * er - pi * ei;
      float ni = pr * ei + pi * er;
      pr = nr; pi = ni;
    }
  }
}
template <int B, int S>
__device__ __forceinline__ void fft_store16(float2* lds, int w, const float (&xr)[16], const float (&xi)[16]) {
  const int base = (w / S) * B + (w % S);
#pragma unroll
  for (int m = 0; m < 16; ++m) lds[PH(base + m * S)] = make_float2(xr[m], xi[m]);
}
template <int B, int S>
__device__ __forceinline__ void fft_load16(const float2* lds, int w, float (&xr)[16], float (&xi)[16]) {
  const int base = (w / S) * B + (w % S);
#pragma unroll
  for (int m = 0; m < 16; ++m) { float2 v = lds[PH(base + m * S)]; xr[m] = v.x; xi[m] = v.y; }
}
template <int B, int S>
__device__ __forceinline__ void fwd16(int w, float (&xr)[16], float (&xi)[16]) {
  dif16(xr, xi);
  const float rev = (float)(w % S) * (1.f / (float)B);
  twiddle16(xr, xi, __builtin_amdgcn_cosf(rev), -__builtin_amdgcn_sinf(rev));
}
template <int B, int S>
__device__ __forceinline__ void inv16(int w, float (&xr)[16], float (&xi)[16]) {
  const float rev = (float)(w % S) * (1.f / (float)B);
  twiddle16(xr, xi, __builtin_amdgcn_cosf(rev), __builtin_amdgcn_sinf(rev));
  dit16(xr, xi);
}
template <int B, int S, bool INV>
__device__ __forceinline__ void fft_pass16(float2* lds, int tid) {
  for (int w = tid; w < FFT_N / 16; w += NTHREADS) {
    float xr[16], xi[16];
    fft_load16<B, S>(lds, w, xr, xi);
    if (INV) inv16<B, S>(w, xr, xi); else fwd16<B, S>(w, xr, xi);
    fft_store16<B, S>(lds, w, xr, xi);
  }
}
__device__ __forceinline__ void fft_pass4(float2* lds, const h16x2* KF, int tid) {
  for (int w = tid; w < FFT_N / 4; w += NTHREADS) {
    const int p0 = PH(4 * w);
    float2 x0 = lds[p0], x1 = lds[p0 + 1], x2 = lds[p0 + 2], x3 = lds[p0 + 3];
    float2 a0 = make_float2(x0.x + x2.x, x0.y + x2.y), a2 = make_float2(x0.x - x2.x, x0.y - x2.y);
    float2 a1 = make_float2(x1.x + x3.x, x1.y + x3.y), d = make_float2(x1.x - x3.x, x1.y - x3.y);
    float2 a3 = make_float2(d.y, -d.x);
    float2 y0 = make_float2(a0.x + a1.x, a0.y + a1.y), y1 = make_float2(a0.x - a1.x, a0.y - a1.y);
    float2 y2 = make_float2(a2.x + a3.x, a2.y + a3.y), y3 = make_float2(a2.x - a3.x, a2.y - a3.y);
    if (KF) {
      const h16x8 kh = *(const h16x8*)(KF + 4 * w);
      constexpr float KS = 16.f / (float)FFT_N;
      float4 k01 = make_float4((float)kh[0] * KS, (float)kh[1] * KS, (float)kh[2] * KS, (float)kh[3] * KS);
      float4 k23 = make_float4((float)kh[4] * KS, (float)kh[5] * KS, (float)kh[6] * KS, (float)kh[7] * KS);
      float2 t;
      t = make_float2(y0.x * k01.x - y0.y * k01.y, y0.x * k01.y + y0.y * k01.x); y0 = t;
      t = make_float2(y1.x * k01.z - y1.y * k01.w, y1.x * k01.w + y1.y * k01.z); y1 = t;
      t = make_float2(y2.x * k23.x - y2.y * k23.y, y2.x * k23.y + y2.y * k23.x); y2 = t;
      t = make_float2(y3.x * k23.z - y3.y * k23.w, y3.x * k23.w + y3.y * k23.z); y3 = t;
      float2 b0 = make_float2(y0.x + y1.x, y0.y + y1.y), b1 = make_float2(y0.x - y1.x, y0.y - y1.y);
      float2 b2 = make_float2(y2.x + y3.x, y2.y + y3.y), b3 = make_float2(y2.x - y3.x, y2.y - y3.y);
      float2 b3i = make_float2(-b3.y, b3.x);
      y0 = make_float2(b0.x + b2.x, b0.y + b2.y);
      y2 = make_float2(b0.x - b2.x, b0.y - b2.y);
      y1 = make_float2(b1.x + b3i.x, b1.y + b3i.y);
      y3 = make_float2(b1.x - b3i.x, b1.y - b3i.y);
    }
    lds[p0] = y0; lds[p0 + 1] = y1; lds[p0 + 2] = y2; lds[p0 + 3] = y3;
  }
}

__device__ __forceinline__ void phase_hyena_fft(KP P, int ly, float2* lds) {
  LAUNDER_IDS
  const int tid = TIDX;
  for (int c = BIDX; c < 256; c += GDIM) {
    const float bias0 = P->hy_bias[ly * 512 + c], bias1 = P->hy_bias[ly * 512 + 256 + c];
    const float* hw = P->hy_conv_w + ly * 3 * 768;
    const float* hb = P->hy_conv_b + ly * 768;
    const float wv0 = hw[512 + c], wv1 = hw[768 + 512 + c], wv2 = hw[1536 + 512 + c], bv = hb[512 + c];
    const float wa0 = hw[c], wa1 = hw[768 + c], wa2 = hw[1536 + c], ba = hb[c];
    const float wb0 = hw[256 + c], wb1 = hw[768 + 256 + c], wb2 = hw[1536 + 256 + c], bb = hb[256 + c];
    h16x2* KF0 = P->KFb + ((size_t)c * 2 + 0) * FFT_N;
    h16x2* KF1 = P->KFb + ((size_t)c * 2 + 1) * FFT_N;
    {
      const _Float16* f0 = P->filtT + (size_t)(0 + c) * L;
      const _Float16* b0 = P->filtT + (size_t)(256 + c) * L;
      const _Float16* f1 = P->filtT + (size_t)(512 + c) * L;
      const _Float16* b1 = P->filtT + (size_t)(768 + c) * L;
      __syncthreads();
      for (int w = tid; w < 1024; w += NTHREADS) {
        float xr[16], xi[16];
#pragma unroll
        for (int m = 0; m < 16; ++m) {
          const int n = m * 1024 + w;
          if (m < 8) { xr[m] = f0[n]; xi[m] = f1[n]; }
          else if (n == L) { xr[m] = 0.f; xi[m] = 0.f; }
          else { xr[m] = b0[FFT_N - n]; xi[m] = b1[FFT_N - n]; }
        }
        fwd16<16384, 1024>(w, xr, xi);
        fft_store16<16384, 1024>(lds, w, xr, xi);
      }
      __syncthreads();
      fft_pass16<1024, 64, false>(lds, tid);
      __syncthreads();
      fft_pass16<64, 4, false>(lds, tid);
      __syncthreads();
      fft_pass4(lds, nullptr, tid);
      __syncthreads();
      const float sc = 0.5f / 16.f;
      for (int pos = tid; pos < FFT_N; pos += NTHREADS) {
        int f = (int)(__brev((unsigned)pos) >> 18);
        int fp = (FFT_N - f) & (FFT_N - 1);
        int posp = (int)(__brev((unsigned)fp) >> 18);
        float2 W = lds[PH(pos)], Wp = lds[PH(posp)];
        float sr = W.x + Wp.x, si = W.y - Wp.y;
        float dr = W.x - Wp.x, di = W.y + Wp.y;
        KF0[pos] = h16x2{(_Float16)(sr * sc), (_Float16)(si * sc)};
        KF1[pos] = h16x2{(_Float16)(di * sc), (_Float16)(-dr * sc)};
      }
      __threadfence_block();
      __syncthreads();
    }
    const float* rv0 = P->huT + ((size_t)0 * 768 + 512 + c) * L;
    const float* rv1 = P->huT + ((size_t)1 * 768 + 512 + c) * L;
    const float* ra0 = P->huT + ((size_t)0 * 768 + c) * L;
    const float* ra1 = P->huT + ((size_t)1 * 768 + c) * L;
    const float* rb0 = P->huT + ((size_t)0 * 768 + 256 + c) * L;
    const float* rb1 = P->huT + ((size_t)1 * 768 + 256 + c) * L;
#define HCONV(ptr, n, w0, w1, w2, bq) ((w0) * ((n) > 0 ? (ptr)[(n) - 1] : 0.f) + (w1) * (ptr)[(n)] + (w2) * ((n) < L - 1 ? (ptr)[(n) + 1] : 0.f) + (bq))
    float* v10 = P->v1T + ((size_t)0 * 256 + c) * L;
    float* v11 = P->v1T + ((size_t)1 * 256 + c) * L;
    float* o0 = P->ohyT + ((size_t)0 * 256 + c) * L;
    float* o1 = P->ohyT + ((size_t)1 * 256 + c) * L;
    for (int w = tid; w < 1024; w += NTHREADS) {
      float xr[16], xi[16];
#pragma unroll
      for (int m = 0; m < 16; ++m) {
        if (m < 8) { const int n = m * 1024 + w; xr[m] = HCONV(rv0, n, wv0, wv1, wv2, bv); xi[m] = HCONV(rv1, n, wv0, wv1, wv2, bv); }
        else { xr[m] = 0.f; xi[m] = 0.f; }
      }
      fwd16<16384, 1024>(w, xr, xi);
      fft_store16<16384, 1024>(lds, w, xr, xi);
    }
    __syncthreads();
    fft_pass16<1024, 64, false>(lds, tid);
    __syncthreads();
    fft_pass16<64, 4, false>(lds, tid);
    __syncthreads();
    fft_pass4(lds, KF0, tid);
    __syncthreads();
    fft_pass16<64, 4, true>(lds, tid);
    __syncthreads();
    fft_pass16<1024, 64, true>(lds, tid);
    __syncthreads();
    for (int w = tid; w < 1024; w += NTHREADS) {
      float xr[16], xi[16];
      fft_load16<16384, 1024>(lds, w, xr, xi);
      inv16<16384, 1024>(w, xr, xi);
      float hv0[8], hv1[8], ha0[8], ha1[8];
#pragma unroll
      for (int m = 0; m < 8; ++m) {
        const int n = m * 1024 + w;
        hv0[m] = HCONV(rv0, n, wv0, wv1, wv2, bv); hv1[m] = HCONV(rv1, n, wv0, wv1, wv2, bv);
        ha0[m] = HCONV(ra0, n, wa0, wa1, wa2, ba); ha1[m] = HCONV(ra1, n, wa0, wa1, wa2, ba);
      }
#pragma unroll
      for (int m = 0; m < 16; ++m) {
        if (m < 8) {
          const int n = m * 1024 + w;
          float a = (xr[m] + bias0 * hv0[m]) * ha0[m];
          float bq = (xi[m] + bias0 * hv1[m]) * ha1[m];
          v10[n] = a; v11[n] = bq;
          xr[m] = a; xi[m] = bq;
        } else { xr[m] = 0.f; xi[m] = 0.f; }
      }
      fwd16<16384, 1024>(w, xr, xi);
      fft_store16<16384, 1024>(lds, w, xr, xi);
    }
    __syncthreads();
    fft_pass16<1024, 64, false>(lds, tid);
    __syncthreads();
    fft_pass16<64, 4, false>(lds, tid);
    __syncthreads();
    fft_pass4(lds, KF1, tid);
    __syncthreads();
    fft_pass16<64, 4, true>(lds, tid);
    __syncthreads();
    fft_pass16<1024, 64, true>(lds, tid);
    __syncthreads();
    for (int w = tid; w < 1024; w += NTHREADS) {
      float xr[16], xi[16];
      fft_load16<16384, 1024>(lds, w, xr, xi);
      inv16<16384, 1024>(w, xr, xi);
      float pv0[8], pv1[8], hb0[8], hb1[8];
#pragma unroll
      for (int m = 0; m < 8; ++m) {
        const int n = m * 1024 + w;
        pv0[m] = v10[n]; pv1[m] = v11[n];
        hb0[m] = HCONV(rb0, n, wb0, wb1, wb2, bb); hb1[m] = HCONV(rb1, n, wb0, wb1, wb2, bb);
      }
#pragma unroll
      for (int m = 0; m < 8; ++m) {
        const int n = m * 1024 + w;
        o0[n] = (xr[m] + bias1 * pv0[m]) * hb0[m];
        o1[n] = (xi[m] + bias1 * pv1[m]) * hb1[m];
      }
    }
    __syncthreads();
  }
}

constexpr int SROW = 272;
constexpr int SMAT = 128 * SROW;
template <int MT, int NT, int K>
__device__ __forceinline__ void lds_mma(const char* sA, const char* sB, int arow0, int brow0, f32x4 (&acc)[MT][NT], int fr, int fq) {
#pragma unroll
  for (int k0 = 0; k0 < K; k0 += 32) {
    bf16x8 af[MT], bfr[NT];
#pragma unroll
    for (int m = 0; m < MT; ++m) af[m] = *(const bf16x8*)(sA + (arow0 + m * 16 + fr) * SROW + (k0 + fq * 8) * 2);
#pragma unroll
    for (int n = 0; n < NT; ++n) bfr[n] = *(const bf16x8*)(sB + (brow0 + n * 16 + fr) * SROW + (k0 + fq * 8) * 2);
#pragma unroll
    for (int m = 0; m < MT; ++m)
#pragma unroll
      for (int n = 0; n < NT; ++n) acc[m][n] = __builtin_amdgcn_mfma_f32_16x16x32_bf16(af[m], bfr[n], acc[m][n], 0, 0, 0);
  }
}
__device__ __forceinline__ void ssd_cumsum(const float* dtv, size_t row0, int col, float a, int dir, int lane, float* sAcs, float* sdt) {
  float d0 = dtv[(row0 + 2 * lane) * 8 + col], d1 = dtv[(row0 + 2 * lane + 1) * 8 + col];
  float incl = (d0 + d1) * a;
#pragma unroll
  for (int o = 1; o < 64; o <<= 1) {
    float v = __shfl_up(incl, o);
    if (lane >= o) incl += v;
  }
  float tot = __shfl(incl, 63);
  float acs0, acs1;
  if (dir == 0) { acs0 = incl - d1 * a; acs1 = incl; }
  else { acs0 = tot - (incl - d1 * a) + d0 * a; acs1 = tot - incl + d1 * a; }
  sAcs[2 * lane] = acs0; sAcs[2 * lane + 1] = acs1;
  sdt[2 * lane] = d0; sdt[2 * lane + 1] = d1;
  if (lane == 0) sAcs[128] = tot;
}

__device__ __forceinline__ void phase_ssd1(KP P, int ly, char* smem) {
  LAUNDER_IDS
  const int tid = TIDX, lane = tid & 63, wid = tid >> 6, fr = lane & 15, fq = lane >> 4;
  char* sC = smem;
  char* sB = smem + SMAT;
  char* sBT = smem + 2 * SMAT;
  float* sAcs4 = (float*)(smem + 3 * SMAT);
  for (int it = BIDX; it < 256; it += GDIM) {
    const int g = it & 1, c = (it >> 1) & 63, b = it >> 7;
    const size_t row0 = (size_t)b * L + c * 128;
    __syncthreads();
    {
      const float* cw = P->ssm_conv_w + ly * 5 * 768;
      const float* cb = P->ssm_conv_b + ly * 768;
      const int lch = c * 128;
      const bf16_t* __restrict__ xbr = P->xbcr;
      float* __restrict__ xbo = P->xbc;
      {
        const int q = tid & 63;
        const int col = (q < 32) ? (256 + g * 128 + q * 4) : (512 + g * 128 + (q - 32) * 4);
        f32x4 w0 = *(const f32x4*)(cw + col), w1 = *(const f32x4*)(cw + 768 + col), w2 = *(const f32x4*)(cw + 2 * 768 + col);
        f32x4 w3 = *(const f32x4*)(cw + 3 * 768 + col), w4 = *(const f32x4*)(cw + 4 * 768 + col), bb = *(const f32x4*)(cb + col);
        const bf16_t* xcol = xbr + (size_t)b * L * 768 + col;
#pragma unroll 1
        for (int tb = 0; tb < 4; ++tb) {
          u32x2 xq[4][5];
#pragma unroll
          for (int k = 0; k < 4; ++k) {
            const int l = lch + (tid >> 6) + 8 * (4 * tb + k);
#pragma unroll
            for (int dd = 0; dd < 5; ++dd) {
              int ld = l + dd - 2; ld = ld < 0 ? 0 : (ld > L - 1 ? L - 1 : ld);
              xq[k][dd] = *(const u32x2*)(xcol + (size_t)ld * 768);
            }
          }
#pragma unroll
          for (int k = 0; k < 4; ++k) {
            const int t = (tid >> 6) + 8 * (4 * tb + k);
            const int l = lch + t;
            f32x4 a = bb + w2 * unpack4(xq[k][2]);
            a += w0 * (l >= 2 ? 1.f : 0.f) * unpack4(xq[k][0]);
            a += w1 * (l >= 1 ? 1.f : 0.f) * unpack4(xq[k][1]);
            a += w3 * (l + 1 < L ? 1.f : 0.f) * unpack4(xq[k][3]);
            a += w4 * (l + 2 < L ? 1.f : 0.f) * unpack4(xq[k][4]);
            f32x4 o = {siluf(a[0]), siluf(a[1]), siluf(a[2]), siluf(a[3])};
            *(f32x4*)(xbo + (row0 + t) * 768 + col) = o;
            u32x2 pk = {pack2(o[0], o[1]), pack2(o[2], o[3])};
            if (q < 32) {
              const int n0 = q * 4;
              *(u32x2*)(sB + t * SROW + n0 * 2) = pk;
              *(bf16_t*)(sBT + (n0 + 0) * SROW + t * 2) = (bf16_t)(pk[0] & 0xffffu);
              *(bf16_t*)(sBT + (n0 + 1) * SROW + t * 2) = (bf16_t)(pk[0] >> 16);
              *(bf16_t*)(sBT + (n0 + 2) * SROW + t * 2) = (bf16_t)(pk[1] & 0xffffu);
              *(bf16_t*)(sBT + (n0 + 3) * SROW + t * 2) = (bf16_t)(pk[1] >> 16);
            } else {
              *(u32x2*)(sC + t * SROW + (q - 32) * 8) = pk;
            }
          }
        }
      }
      {
        const int q = tid & 31;
        const int col = g * 128 + q * 4;
        f32x4 w0 = *(const f32x4*)(cw + col), w1 = *(const f32x4*)(cw + 768 + col), w2 = *(const f32x4*)(cw + 2 * 768 + col);
        f32x4 w3 = *(const f32x4*)(cw + 3 * 768 + col), w4 = *(const f32x4*)(cw + 4 * 768 + col), bb = *(const f32x4*)(cb + col);
        const bf16_t* xcol = xbr + (size_t)b * L * 768 + col;
#pragma unroll 1
        for (int tb = 0; tb < 2; ++tb) {
          u32x2 xq[4][5];
#pragma unroll
          for (int k = 0; k < 4; ++k) {
            const int l = lch + (tid >> 5) + 16 * (4 * tb + k);
#pragma unroll
            for (int dd = 0; dd < 5; ++dd) {
              int ld = l + dd - 2; ld = ld < 0 ? 0 : (ld > L - 1 ? L - 1 : ld);
              xq[k][dd] = *(const u32x2*)(xcol + (size_t)ld * 768);
            }
          }
#pragma unroll
          for (int k = 0; k < 4; ++k) {
            const int t = (tid >> 5) + 16 * (4 * tb + k);
            const int l = lch + t;
            f32x4 a = bb + w2 * unpack4(xq[k][2]);
            a += w0 * (l >= 2 ? 1.f : 0.f) * unpack4(xq[k][0]);
            a += w1 * (l >= 1 ? 1.f : 0.f) * unpack4(xq[k][1]);
            a += w3 * (l + 1 < L ? 1.f : 0.f) * unpack4(xq[k][3]);
            a += w4 * (l + 2 < L ? 1.f : 0.f) * unpack4(xq[k][4]);
            f32x4 o = {siluf(a[0]), siluf(a[1]), siluf(a[2]), siluf(a[3])};
            *(f32x4*)(xbo + (row0 + t) * 768 + col) = o;
          }
        }
      }
    }
    __syncthreads();
    f32x4 G[4][2];
#pragma unroll
    for (int m = 0; m < 4; ++m)
#pragma unroll
      for (int n = 0; n < 2; ++n) G[m][n] = f32x4{0.f, 0.f, 0.f, 0.f};
    const int gl0 = (wid >> 2) * 64, gs0 = (wid & 3) * 32;
    lds_mma<4, 2, 128>(sC, sB, gl0, gs0, G, fr, fq);
    __syncthreads();
    if (wid < 4) {
      const int h = g * 2 + (wid >> 1), dir = wid & 1;
      const float a = -expf(P->ssm_a_log[ly * 8 + dir * 4 + h]);
      float* sA_ = sAcs4 + wid * 264;
      ssd_cumsum(P->dtv, row0, dir * 4 + h, a, dir, lane, sA_, sA_ + 132);
      if (lane == 0) P->cdec[(((size_t)b * 64 + c) * 4 + h) * 2 + dir] = expf(sA_[128]);
    }
    __syncthreads();
    float xl[16];
    {
      const float* xg = P->xbc + row0 * 768 + (g * 2) * 64 + (tid & 63);
#pragma unroll
      for (int k = 0; k < 16; ++k) xl[k] = xg[(size_t)((tid >> 6) + 8 * k) * 768];
    }
#pragma unroll 1
    for (int hd = 0; hd < 4; ++hd) {
      const int h = g * 2 + (hd >> 1), dir = hd & 1;
      const size_t sidx = (((size_t)b * 64 + c) * 4 + h) * 2 + dir;
      const float* sAcs = sAcs4 + hd * 264;
      const float* sdt = sAcs + 132;
      const float tot = sAcs[128];
      {
#pragma unroll
        for (int k = 0; k < 16; ++k) {
          const int t = (tid >> 6) + 8 * k, pp = tid & 63;
          const float xv = xl[k] * sdt[t];
          *(bf16_t*)(sB + pp * SROW + t * 2) = f2bf(xv);
          *(bf16_t*)(sB + 64 * SROW + pp * SROW + t * 2) = f2bf(xv * __expf(tot - sAcs[t]));
        }
      }
      {
        float asx[2];
#pragma unroll
        for (int n = 0; n < 2; ++n) asx[n] = sAcs[gs0 + n * 16 + fr];
#pragma unroll
        for (int m = 0; m < 4; ++m)
#pragma unroll
          for (int j = 0; j < 4; ++j) {
            const int l = gl0 + m * 16 + fq * 4 + j;
            const float al = sAcs[l];
#pragma unroll
            for (int n = 0; n < 2; ++n) {
              const int sx = gs0 + n * 16 + fr;
              const bool ok = dir ? (sx >= l) : (sx <= l);
              const float ev = __expf(fminf(al - asx[n], 0.f));
              const float v = ok ? G[m][n][j] * ev : 0.f;
              *(bf16_t*)(sC + l * SROW + sx * 2) = f2bf(v);
            }
          }
      }
      __syncthreads();
      {
        f32x4 Y[2][2];
#pragma unroll
        for (int m = 0; m < 2; ++m)
#pragma unroll
          for (int n = 0; n < 2; ++n) Y[m][n] = f32x4{0.f, 0.f, 0.f, 0.f};
        const int yl0 = (wid >> 1) * 32, yp0 = (wid & 1) * 32;
        lds_mma<2, 2, 128>(sC, sB, yl0, yp0, Y, fr, fq);
        float* yo = dir ? P->yb : P->yf;
#pragma unroll
        for (int m = 0; m < 2; ++m)
#pragma unroll
          for (int n = 0; n < 2; ++n)
#pragma unroll
            for (int j = 0; j < 4; ++j) {
              int t = yl0 + m * 16 + fq * 4 + j, pp = yp0 + n * 16 + fr;
              yo[(row0 + t) * 256 + h * 64 + pp] = Y[m][n][j];
            }
      }
      {
        f32x4 S[2][2];
#pragma unroll
        for (int m = 0; m < 2; ++m)
#pragma unroll
          for (int n = 0; n < 2; ++n) S[m][n] = f32x4{0.f, 0.f, 0.f, 0.f};
        const int sp0 = (wid >> 2) * 32, sn0 = (wid & 3) * 32;
        lds_mma<2, 2, 128>(sB + 64 * SROW, sBT, sp0, sn0, S, fr, fq);
        float* so = P->states + sidx * 8192;
#pragma unroll
        for (int m = 0; m < 2; ++m)
#pragma unroll
          for (int n = 0; n < 2; ++n)
#pragma unroll
            for (int j = 0; j < 4; ++j) {
              int pp = sp0 + m * 16 + fq * 4 + j, nn = sn0 + n * 16 + fr;
              so[pp * 128 + nn] = S[m][n][j];
            }
      }
      if (hd < 3) {
        const float* xg = P->xbc + row0 * 768 + (g * 2 + ((hd + 1) >> 1)) * 64 + (tid & 63);
#pragma unroll
        for (int k = 0; k < 16; ++k) xl[k] = xg[(size_t)((tid >> 6) + 8 * k) * 768];
      }
      __syncthreads();
    }
  }
}

__device__ __forceinline__ void phase_ssd_scan(KP P) {
  LAUNDER_IDS
  for (int e = BIDX * NTHREADS + TIDX; e < 131072; e += GDIM * NTHREADS) {
    const int pn = e & 8191, dir = (e >> 13) & 1, h = (e >> 14) & 3, b = e >> 16;
    float st = 0.f;
#pragma unroll
    for (int half = 0; half < 2; ++half) {
      float sv[32], dv[32];
#pragma unroll
      for (int k = 0; k < 32; ++k) {
        const int kk = half * 32 + k;
        const int c = dir ? (63 - kk) : kk;
        const size_t sidx = (((size_t)b * 64 + c) * 4 + h) * 2 + dir;
        sv[k] = P->states[sidx * 8192 + pn];
        dv[k] = P->cdec[sidx];
      }
#pragma unroll
      for (int k = 0; k < 32; ++k) {
        const int kk = half * 32 + k;
        const int c = dir ? (63 - kk) : kk;
        const size_t sidx = (((size_t)b * 64 + c) * 4 + h) * 2 + dir;
        P->prevb[sidx * 8192 + pn] = f2bf(st);
        st = st * dv[k] + sv[k];
      }
    }
  }
}

__device__ __forceinline__ void phase_ssd3(KP P, int ly, char* smem) {
  LAUNDER_IDS
  const int tid = TIDX, lane = tid & 63, wid = tid >> 6, fr = lane & 15, fq = lane >> 4;
  char* sC = smem;
  char* sP = smem + SMAT;
  float* sAcs4 = (float*)(smem + 2 * SMAT);
  for (int it = BIDX; it < 256; it += GDIM) {
    const int g = it & 1, c = (it >> 1) & 63, b = it >> 7;
    const size_t row0 = (size_t)b * L + c * 128;
    __syncthreads();
    {
      const float* cg = P->xbc + row0 * 768 + 512 + g * 128 + (tid & 63) * 2;
      float2 cl[16];
#pragma unroll
      for (int k = 0; k < 16; ++k) cl[k] = *(const float2*)(cg + (size_t)((tid >> 6) + 8 * k) * 768);
#pragma unroll
      for (int k = 0; k < 16; ++k) *(uint32_t*)(sC + ((tid >> 6) + 8 * k) * SROW + (tid & 63) * 4) = pack2(cl[k].x, cl[k].y);
    }
    if (wid < 4) {
      const int h = g * 2 + (wid >> 1), dir = wid & 1;
      const float a = -expf(P->ssm_a_log[ly * 8 + dir * 4 + h]);
      float* sA_ = sAcs4 + wid * 264;
      ssd_cumsum(P->dtv, row0, dir * 4 + h, a, dir, lane, sA_, sA_ + 132);
    }
    u32x4 pgv[2];
    {
      const u32x4* pg = (const u32x4*)(P->prevb + ((((size_t)b * 64 + c) * 4 + g * 2) * 2) * 8192);
      pgv[0] = pg[tid]; pgv[1] = pg[tid + NTHREADS];
    }
#pragma unroll 1
    for (int hd = 0; hd < 4; ++hd) {
      const int h = g * 2 + (hd >> 1), dir = hd & 1;
      const float* sAcs = sAcs4 + hd * 264;
#pragma unroll
      for (int k = 0; k < 2; ++k) {
        const int i = tid + k * NTHREADS;
        *(u32x4*)(sP + (i >> 4) * SROW + (i & 15) * 16) = pgv[k];
      }
      {
        const int hn = (hd < 3) ? (hd + 1) : 3;
        const u32x4* pg = (const u32x4*)(P->prevb + ((((size_t)b * 64 + c) * 4 + g * 2 + (hn >> 1)) * 2 + (hn & 1)) * 8192);
        pgv[0] = pg[tid]; pgv[1] = pg[tid + NTHREADS];
      }
      __syncthreads();
      f32x4 Y[2][2];
#pragma unroll
      for (int m = 0; m < 2; ++m)
#pragma unroll
        for (int n = 0; n < 2; ++n) Y[m][n] = f32x4{0.f, 0.f, 0.f, 0.f};
      const int yl0 = (wid >> 1) * 32, yp0 = (wid & 1) * 32;
      lds_mma<2, 2, 128>(sC, sP, yl0, yp0, Y, fr, fq);
      float* yo = (dir ? P->yb : P->yf) + row0 * 256 + h * 64 + yp0 + fr;
      float yv[2][4][2];
#pragma unroll
      for (int m = 0; m < 2; ++m)
#pragma unroll
        for (int j = 0; j < 4; ++j)
#pragma unroll
          for (int n = 0; n < 2; ++n) yv[m][j][n] = yo[(size_t)(yl0 + m * 16 + fq * 4 + j) * 256 + n * 16];
#pragma unroll
      for (int m = 0; m < 2; ++m)
#pragma unroll
        for (int j = 0; j < 4; ++j) {
          const int t = yl0 + m * 16 + fq * 4 + j;
          const float sc = __expf(sAcs[t]);
#pragma unroll
          for (int n = 0; n < 2; ++n) yo[(size_t)t * 256 + n * 16] = yv[m][j][n] + sc * Y[m][n][j];
        }
      __syncthreads();
    }
  }
}

__device__ __forceinline__ void phase_prep3b(KP P, float* sm) {
  LAUNDER_IDS
  const float qs = 0.14724445f;
  for (int t = BIDX; t < T / 64; t += GDIM) {
    const int row0 = t * 64;
    const int b = row0 / L, l0 = row0 % L;
    for (int i = TIDX; i < 64 * 8 * 48; i += NTHREADS) {
      int jj = i % 48, h = (i / 48) & 7, r = i / (48 * 8);
      int row = row0 + r;
      size_t bh = (size_t)(b * 8 + h);
      const float* qr = P->qraw + (size_t)row * 768 + h * 96;
      bf16_t* Q = P->Qb + (bh * L + l0 + r) * 96;
      if (jj < 32) {
        *(uint32_t*)(Q + 2 * jj) = pack2(qr[2 * jj] * qs, qr[2 * jj + 1] * qs);
      } else {
        int jf = jj - 32;
        float cs, sn;
        rope_cs(P->pos[row], jf, cs, sn);
        float q1 = qr[64 + jf], q2 = qr[80 + jf];
        Q[64 + jf] = f2bf((q1 * cs - q2 * sn) * qs);
        Q[80 + jf] = f2bf((q2 * cs + q1 * sn) * qs);
      }
    }
    for (int i = TIDX; i < 64 * 8 * 32; i += NTHREADS) {
      int jj = i & 31, h = (i >> 5) & 7, r = i >> 8;
      int row = row0 + r;
      size_t bh = (size_t)(b * 8 + h);
      const float* kvr = P->kvraw + (size_t)row * 1024 + h * 128;
      *(uint32_t*)(P->Kn + (bh * L + l0 + r) * 64 + 2 * jj) = pack2(kvr[2 * jj], kvr[2 * jj + 1]);
    }
    for (int i = TIDX; i < 64 * 16; i += NTHREADS) {
      int jf = i & 15, r = i >> 4;
      int row = row0 + r;
      const float* kr = P->proj + (size_t)row * NIN + C_KR;
      float cs, sn;
      rope_cs(P->pos[row], jf, cs, sn);
      float k1 = kr[jf], k2 = kr[16 + jf];
      P->Kr[(size_t)row * 32 + jf] = f2bf(k1 * cs - k2 * sn);
      P->Kr[(size_t)row * 32 + 16 + jf] = f2bf(k2 * cs + k1 * sn);
    }
    for (int h = 0; h < 8; ++h) {
      size_t bh = (size_t)(b * 8 + h);
      __syncthreads();
      for (int i = TIDX; i < 64 * 64; i += NTHREADS) {
        int r = i >> 6, c = i & 63;
        sm[r * 65 + c] = P->kvraw[(size_t)(row0 + r) * 1024 + h * 128 + 64 + c];
      }
      __syncthreads();
      for (int i = TIDX; i < 64 * 32; i += NTHREADS) {
        int dv = i >> 5, lp = i & 31;
        const int kp = 2 * lp, kperm = (kp & ~12) | ((kp & 4) << 1) | ((kp & 8) >> 1);
        *(uint32_t*)(P->Vt + (bh * 64 + dv) * L + l0 + kperm) = pack2(sm[(2 * lp) * 65 + dv], sm[(2 * lp + 1) * 65 + dv]);
      }
    }
  }
}

constexpr int AK_ROW = 208, AV_ROW = 264;
constexpr int AK_BYTES = 128 * AK_ROW, AV_BYTES = 64 * AV_ROW, ABUF = AK_BYTES + AV_BYTES;
#define MFMA32(a, b, c) __builtin_amdgcn_mfma_f32_32x32x16_bf16((a), (b), (c), 0, 0, 0)

__device__ __forceinline__ void attn_rowmax_init(const f32x16& sc, float& m) {
  float m0 = fmaxf(fmaxf(sc[0], sc[1]), fmaxf(sc[2], sc[3])), m1 = fmaxf(fmaxf(sc[4], sc[5]), fmaxf(sc[6], sc[7]));
  float m2 = fmaxf(fmaxf(sc[8], sc[9]), fmaxf(sc[10], sc[11])), m3 = fmaxf(fmaxf(sc[12], sc[13]), fmaxf(sc[14], sc[15]));
  float mx = fmaxf(fmaxf(m0, m1), fmaxf(m2, m3));
  mx = fmaxf(mx, __shfl_xor(mx, 32));
  m = __uint_as_float((unsigned)f2bf(mx) << 16);
}

__device__ __forceinline__ void attn_softmax32(f32x16& sc, float& m, float& lsum, f32x16& o0, f32x16& o1, bf16x8 (&pf)[2]) {
  f32v2_t d[8];
  const f32v2_t mm = {m, m};
#pragma unroll
  for (int i = 0; i < 8; ++i) { const f32v2_t s2 = {sc[2 * i], sc[2 * i + 1]}; d[i] = s2 - mm; }
  const float t0 = fmaxf(fmaxf(d[0][0], d[0][1]), d[1][0]);
  const float t1 = fmaxf(fmaxf(d[1][1], d[2][0]), d[2][1]);
  const float t2 = fmaxf(fmaxf(d[3][0], d[3][1]), d[4][0]);
  const float t3 = fmaxf(fmaxf(d[4][1], d[5][0]), d[5][1]);
  const float t4 = fmaxf(fmaxf(d[6][0], d[6][1]), d[7][0]);
  float mx = fmaxf(fmaxf(fmaxf(t0, t1), t2), fmaxf(fmaxf(t3, t4), d[7][1]));
  if (__any(mx > 8.f)) {
    mx = fmaxf(mx, __shfl_xor(mx, 32));
    const float delta = fmaxf(mx, 0.f);
    const float alpha = __builtin_amdgcn_exp2f(-delta);
    m += delta;
    lsum *= alpha;
#pragma unroll
    for (int i = 0; i < 16; ++i) { o0[i] *= alpha; o1[i] *= alpha; }
    const f32v2_t dd = {delta, delta};
#pragma unroll
    for (int i = 0; i < 8; ++i) d[i] -= dd;
  }
  f32v2_t ps0 = {0.f, 0.f}, ps1 = {0.f, 0.f};
#pragma unroll
  for (int i = 0; i < 8; i += 2) {
    d[i][0] = __builtin_amdgcn_exp2f(d[i][0]); d[i][1] = __builtin_amdgcn_exp2f(d[i][1]); ps0 += d[i];
    d[i + 1][0] = __builtin_amdgcn_exp2f(d[i + 1][0]); d[i + 1][1] = __builtin_amdgcn_exp2f(d[i + 1][1]); ps1 += d[i + 1];
  }
  ps0 += ps1;
  lsum += ps0[0] + ps0[1];
  u32x4 t;
  t[0] = pack2(d[0][0], d[0][1]); t[1] = pack2(d[1][0], d[1][1]); t[2] = pack2(d[2][0], d[2][1]); t[3] = pack2(d[3][0], d[3][1]);
  pf[0] = __builtin_bit_cast(bf16x8, t);
  t[0] = pack2(d[4][0], d[4][1]); t[1] = pack2(d[5][0], d[5][1]); t[2] = pack2(d[6][0], d[6][1]); t[3] = pack2(d[7][0], d[7][1]);
  pf[1] = __builtin_bit_cast(bf16x8, t);
}

constexpr int AS_KR = 16384, AS_VT = 24576, ASLOT = 40960;
#define ASB() __builtin_amdgcn_sched_barrier(0)
template <bool PV, bool VRELOAD>
__device__ __forceinline__ void attn_hs(f32x16& oX0, f32x16& oX1, const bf16x8 (&pX)[2], f32x16& sX, const bf16x8 (&qX)[6],
                                        const f32x16& sY, float& mY, float& lY, f32x16& oY0, f32x16& oY1, bf16x8 (&pY)[2],
                                        bf16x8 (&vf)[4], const char* kslot, const int kn_l, const int kr_l,
                                        const char* vslot, const int v_l0, const int v_l1, const float wv,
                                        const s16x4 ones, const s16x4 nmX, s16x4& nmY, const int hh) {
  bf16x8 kf[6];
  f32v2_t d[8];
  if (PV) oX0 = MFMA32(vf[0], pX[0], oX0);
#pragma unroll
  for (int i = 0; i < 4; ++i) d[i] = f32v2_t{sY[2 * i], sY[2 * i + 1]};
  ASB();
  if (PV) oX1 = MFMA32(vf[1], pX[0], oX1);
  kf[0] = *(const bf16x8*)(kslot + kn_l); kf[1] = *(const bf16x8*)(kslot + (kn_l ^ 32));
#pragma unroll
  for (int i = 4; i < 8; ++i) d[i] = f32v2_t{sY[2 * i], sY[2 * i + 1]};
  ASB();
  if (PV) oX0 = MFMA32(vf[2], pX[1], oX0);
  const float t0 = fmaxf(fmaxf(d[0][0], d[0][1]), d[1][0]);
  const float t1 = fmaxf(fmaxf(d[1][1], d[2][0]), d[2][1]);
  const float t2 = fmaxf(fmaxf(d[3][0], d[3][1]), d[4][0]);
  const float t3 = fmaxf(fmaxf(d[4][1], d[5][0]), d[5][1]);
  const float t4 = fmaxf(fmaxf(d[6][0], d[6][1]), d[7][0]);
  ASB();
  if (PV) oX1 = MFMA32(vf[3], pX[1], oX1);
  kf[2] = *(const bf16x8*)(kslot + (kn_l ^ 64)); kf[3] = *(const bf16x8*)(kslot + (kn_l ^ 96));
  kf[4] = *(const bf16x8*)(kslot + kr_l); kf[5] = *(const bf16x8*)(kslot + (kr_l ^ 32));
  float mx = fmaxf(fmaxf(fmaxf(t0, t1), t2), fmaxf(fmaxf(t3, t4), d[7][1]));
  ASB();
  if (__any(mx > 8.f)) {
    mx = fmaxf(mx, __shfl_xor(mx, 32));
    const unsigned mb = (unsigned)f2bf(mY + fmaxf(mx, 0.f));
    const float mnew = __uint_as_float(mb << 16);
    const float delta = mnew - mY;
    const float alpha = __builtin_amdgcn_exp2f(-delta);
    mY = mnew;
    lY *= alpha;
#pragma unroll
    for (int i = 0; i < 16; ++i) { oY0[i] *= alpha; oY1[i] *= alpha; }
    const f32v2_t dd = {delta, delta};
#pragma unroll
    for (int i = 0; i < 8; ++i) d[i] -= dd;
    u32x2 nb = {hh ? 0u : (mb ^ 0x8000u), 0u};
    nmY = __builtin_bit_cast(s16x4, nb);
  }
  f32x16 acc;
#pragma unroll
  for (int i = 0; i < 16; ++i) acc[i] = 0.f;
  acc = __builtin_amdgcn_mfma_f32_32x32x8bf16_1k(ones, nmX, acc, 0, 0, 0);
  acc = MFMA32(kf[0], qX[0], acc);
  if (VRELOAD) {
    vf[0] = *(const bf16x8*)(vslot + v_l0); vf[1] = *(const bf16x8*)(vslot + v_l0 + 8192);
    vf[2] = *(const bf16x8*)(vslot + v_l1); vf[3] = *(const bf16x8*)(vslot + v_l1 + 8192);
  }
  d[0][0] = __builtin_amdgcn_exp2f(d[0][0]); d[0][1] = __builtin_amdgcn_exp2f(d[0][1]);
  d[1][0] = __builtin_amdgcn_exp2f(d[1][0]); d[1][1] = __builtin_amdgcn_exp2f(d[1][1]);
  ASB();
  acc = MFMA32(kf[1], qX[1], acc);
  d[2][0] = __builtin_amdgcn_exp2f(d[2][0]); d[2][1] = __builtin_amdgcn_exp2f(d[2][1]);
  d[3][0] = __builtin_amdgcn_exp2f(d[3][0]); d[3][1] = __builtin_amdgcn_exp2f(d[3][1]);
  f32v2_t ps0 = d[0] + d[2], ps1 = d[1] + d[3];
  ASB();
  acc = MFMA32(kf[2], qX[2], acc);
  d[4][0] = __builtin_amdgcn_exp2f(d[4][0]); d[4][1] = __builtin_amdgcn_exp2f(d[4][1]);
  d[5][0] = __builtin_amdgcn_exp2f(d[5][0]); d[5][1] = __builtin_amdgcn_exp2f(d[5][1]);
  u32x4 t;
  t[0] = pack2(d[0][0], d[0][1]); t[1] = pack2(d[1][0], d[1][1]); t[2] = pack2(d[2][0], d[2][1]); t[3] = pack2(d[3][0], d[3][1]);
  pY[0] = __builtin_bit_cast(bf16x8, t);
  ASB();
  acc = MFMA32(kf[3], qX[3], acc);
  d[6][0] = __builtin_amdgcn_exp2f(d[6][0]); d[6][1] = __builtin_amdgcn_exp2f(d[6][1]);
  d[7][0] = __builtin_amdgcn_exp2f(d[7][0]); d[7][1] = __builtin_amdgcn_exp2f(d[7][1]);
  ps0 += d[4]; ps1 += d[5];
  ASB();
  acc = MFMA32(kf[4], qX[4], acc);
  ps0 += d[6]; ps1 += d[7];
  t[0] = pack2(d[4][0], d[4][1]); t[1] = pack2(d[5][0], d[5][1]); t[2] = pack2(d[6][0], d[6][1]); t[3] = pack2(d[7][0], d[7][1]);
  pY[1] = __builtin_bit_cast(bf16x8, t);
  ASB();
  acc = MFMA32(kf[5], qX[5], acc);
  ps0 += ps1;
  lY = fmaf(ps0[0] + ps0[1], wv, lY);
  ASB();
  sX = acc;
}

__device__ __forceinline__ void phase_attn_mfma(KP P, char* smem) {
  LAUNDER_IDS
  const int tid = TIDX, lane = tid & 63;
  const int wid = __builtin_amdgcn_readfirstlane(tid >> 6);
  const int q32 = lane & 31, hh = lane >> 5;
  const bf16_t* Qb = P->Qb;
  const bf16_t* Kn = P->Kn;
  const bf16_t* Kr = P->Kr;
  const bf16_t* Vt = P->Vt;
  bf16_t* oattn = P->oattn;
  constexpr int NT = L / 128;
  XLAS char* lds = (XLAS char*)smem;
  const int kn_l = q32 * 128 + ((16 * hh) ^ (16 * ((q32 >> 1) & 7)));
  const int kr_l = AS_KR + q32 * 64 + ((16 * hh) ^ (16 * ((q32 >> 2) & 3)));
  const int v_l = AS_VT + q32 * 256 + ((16 * hh) ^ (16 * (q32 & 15)));
  for (int item = BIDX; item < 16 * 16; item += GDIM) {
    const int xg = item & 7, xj = item >> 3;
    const int bh = (xg * 2 + (xj >> 4)) & 15, qb = xj & 15, b = bh >> 3, h = bh & 7;
    const int qrow = qb * 512 + wid * 64 + q32;
    bf16x8 qfA[6], qfB[6];
    {
      const bf16_t* qp = Qb + ((size_t)bh * L + qrow) * 96 + hh * 8;
#pragma unroll
      for (int s = 0; s < 6; ++s) { qfA[s] = *(const bf16x8*)(qp + s * 16); qfB[s] = *(const bf16x8*)(qp + 32 * 96 + s * 16); }
    }
    f32x16 oA0, oA1, oB0, oB1;
#pragma unroll
    for (int i = 0; i < 16; ++i) { oA0[i] = 0.f; oA1[i] = 0.f; oB0[i] = 0.f; oB1[i] = 0.f; }
    float mA = -1e30f, lA = 0.f, mB = -1e30f, lB = 0.f;
    const char* kn_t = (const char*)(Kn + (size_t)bh * L * 64);
    const char* kr_t = (const char*)(Kr + (size_t)b * L * 32);
    const char* vt_t = (const char*)(Vt + (size_t)bh * 64 * L);
#define ATT_DMA(kt_, slot_) do { const size_t _kt = (size_t)(kt_); const unsigned _so = (unsigned)(slot_) + (unsigned)wid * 2048u; \
        \
      const int _ln = (int)__builtin_amdgcn_mbcnt_hi(~0u, __builtin_amdgcn_mbcnt_lo(~0u, 0u)); \
      const int _rk = wid * 16 + (_ln >> 3); const unsigned _gk0 = (unsigned)(_rk * 128 + (((_ln & 7) ^ ((_rk >> 1) & 7)) * 16)); \
      const int _rv = wid * 8 + (_ln >> 4); const unsigned _gv0 = (unsigned)(_rv * (L * 2) + (((_ln & 15) ^ (_rv & 15)) * 16)); \
      const int _rr = wid * 16 + (_ln >> 2); const unsigned _gr = (unsigned)(_rr * 64 + (((_ln & 3) ^ ((_rr >> 2) & 3)) * 16)); \
      __builtin_amdgcn_global_load_lds((const unsigned*)(kn_t + _kt * (128 * 128) + _gk0), (XLAS unsigned*)(lds + _so), 16, 0, 0); \
      __builtin_amdgcn_global_load_lds((const unsigned*)(kn_t + _kt * (128 * 128) + ((_gk0 + 1024u) ^ 64u)), (XLAS unsigned*)(lds + _so + 1024), 16, 0, 0); \
      __builtin_amdgcn_global_load_lds((const unsigned*)(kr_t + _kt * (128 * 64) + _gr), (XLAS unsigned*)(lds + (unsigned)(slot_) + AS_KR + (unsigned)wid * 1024u), 16, 0, 0); \
      __builtin_amdgcn_global_load_lds((const unsigned*)(vt_t + _kt * 256 + _gv0), (XLAS unsigned*)(lds + _so + AS_VT), 16, 0, 0); \
      __builtin_amdgcn_global_load_lds((const unsigned*)(vt_t + _kt * 256 + ((_gv0 + 4u * (L * 2)) ^ 64u)), (XLAS unsigned*)(lds + _so + AS_VT + 1024), 16, 0, 0); } while (0)
    __syncthreads();
    ATT_DMA(0, 0);
    asm volatile("s_waitcnt vmcnt(0)" ::: "memory");
    __syncthreads();
    f32x16 sA, sB;
    bf16x8 pA[2], pB[2], vf[4];
    s16x4 nmA, nmB;
    const s16x4 onesf = __builtin_bit_cast(s16x4, u32x2{hh ? 0u : 0x3f80u, 0u});
#define ATT_EXTRA_AB onesf, nmA, nmB, hh
#define ATT_EXTRA_BA onesf, nmB, nmA, hh
    {
      bf16x8 kf[6];
#pragma unroll
      for (int s = 0; s < 4; ++s) kf[s] = *(const bf16x8*)(smem + (kn_l ^ (32 * s)));
      kf[4] = *(const bf16x8*)(smem + kr_l); kf[5] = *(const bf16x8*)(smem + (kr_l ^ 32));
#pragma unroll
      for (int i = 0; i < 16; ++i) { sA[i] = 0.f; sB[i] = 0.f; }
#pragma unroll
      for (int s = 0; s < 6; ++s) { sA = MFMA32(kf[s], qfA[s], sA); sB = MFMA32(kf[s], qfB[s], sB); }
      attn_rowmax_init(sA, mA); attn_rowmax_init(sB, mB);
      attn_softmax32(sA, mA, lA, oA0, oA1, pA);
#pragma unroll
      for (int i = 0; i < 16; ++i) sB[i] -= mB;
      vf[0] = *(const bf16x8*)(smem + v_l); vf[1] = *(const bf16x8*)(smem + v_l + 8192);
      vf[2] = *(const bf16x8*)(smem + (v_l ^ 32)); vf[3] = *(const bf16x8*)(smem + (v_l ^ 32) + 8192);
    }
    nmA = __builtin_bit_cast(s16x4, u32x2{hh ? 0u : ((__float_as_uint(mA) >> 16) ^ 0x8000u), 0u});
    nmB = __builtin_bit_cast(s16x4, u32x2{hh ? 0u : ((__float_as_uint(mB) >> 16) ^ 0x8000u), 0u});
    if (wid >= 4) __builtin_amdgcn_s_setprio(1);
    int scur = 0, snxt = ASLOT, snn = 2 * ASLOT;
    for (int kt = 0; kt < NT; ++kt) {
      const char* bc = smem + scur;
      const char* bn = smem + snxt;
      const int kn_ = (kt + 1 < NT) ? (kt + 1) : kt;
      ATT_DMA(kn_, snxt);
#pragma unroll
      for (int j = 0; j < 3; ++j) {
        const char* ks = bc + (32 * (j + 1)) * 128 - 0;
        attn_hs<true, false>(oA0, oA1, pA, sA, qfA, sB, mB, lB, oB0, oB1, pB, vf, bc, kn_l + 4096 * (j + 1), kr_l + 2048 * (j + 1),
                             bc, v_l ^ (64 * (j + 1)), v_l ^ (64 * (j + 1) + 32), 1.f, ATT_EXTRA_AB);
        attn_hs<true, true>(oB0, oB1, pB, sB, qfB, sA, mA, lA, oA0, oA1, pA, vf, bc, kn_l + 4096 * (j + 1), kr_l + 2048 * (j + 1),
                            bc, v_l ^ (64 * (j + 1)), v_l ^ (64 * (j + 1) + 32), 1.f, ATT_EXTRA_BA);
        (void)ks;
      }
      asm volatile("s_waitcnt vmcnt(0)" ::: "memory");
      __syncthreads();
      {
        const float wv = (kt + 1 < NT) ? 1.f : 0.f;
        attn_hs<true, false>(oA0, oA1, pA, sA, qfA, sB, mB, lB, oB0, oB1, pB, vf, bn, kn_l, kr_l, bn, v_l, v_l ^ 32, 1.f, ATT_EXTRA_AB);
        attn_hs<true, true>(oB0, oB1, pB, sB, qfB, sA, mA, lA, oA0, oA1, pA, vf, bn, kn_l, kr_l, bn, v_l, v_l ^ 32, wv, ATT_EXTRA_BA);
      }
      const int t_ = scur; scur = snxt; snxt = snn; snn = t_;
    }
#undef ATT_DMA
#undef ATT_EXTRA_AB
#undef ATT_EXTRA_BA
    __builtin_amdgcn_s_setprio(0);
    {
      const float inv = 1.f / (lA + __shfl_xor(lA, 32));
      bf16_t* op = oattn + ((size_t)b * L + qrow) * 512 + h * 64 + 4 * hh;
#pragma unroll
      for (int g = 0; g < 4; ++g) {
        u32x2 w0 = {pack2(oA0[4 * g] * inv, oA0[4 * g + 1] * inv), pack2(oA0[4 * g + 2] * inv, oA0[4 * g + 3] * inv)};
        u32x2 w1 = {pack2(oA1[4 * g] * inv, oA1[4 * g + 1] * inv), pack2(oA1[4 * g + 2] * inv, oA1[4 * g + 3] * inv)};
        *(u32x2*)(op + 8 * g) = w0;
        *(u32x2*)(op + 32 + 8 * g) = w1;
      }
    }
    {
      const float inv = 1.f / (lB + __shfl_xor(lB, 32));
      bf16_t* op = oattn + ((size_t)b * L + qrow + 32) * 512 + h * 64 + 4 * hh;
#pragma unroll
      for (int g = 0; g < 4; ++g) {
        u32x2 w0 = {pack2(oB0[4 * g] * inv, oB0[4 * g + 1] * inv), pack2(oB0[4 * g + 2] * inv, oB0[4 * g + 3] * inv)};
        u32x2 w1 = {pack2(oB1[4 * g] * inv, oB1[4 * g + 1] * inv), pack2(oB1[4 * g + 2] * inv, oB1[4 * g + 3] * inv)};
        *(u32x2*)(op + 8 * g) = w0;
        *(u32x2*)(op + 32 + 8 * g) = w1;
      }
    }
  }
}

__device__ __forceinline__ void phase_prep4(KP P, int ly, float* sm) {
  LAUNDER_IDS
  const int tid = TIDX, lane = tid & 63, wid = tid >> 6;
  const float* gm = P->mla_out_norm + ly * 512;
  const float* gh = P->hy_out_norm + ly * 256;
  const float* gs = P->ssm_norm + ly * 256;
  const float* dsk = P->ssm_d + ly * 4;
  const f32x4 ga = *(const f32x4*)(gm + lane * 8), gb = *(const f32x4*)(gm + lane * 8 + 4);
  const f32x4 gsv = *(const f32x4*)(gs + lane * 4);
  float ghv[4];
#pragma unroll
  for (int i = 0; i < 4; ++i) ghv[i] = gh[lane + 64 * i];
  const float dh = dsk[lane >> 4];
  for (int t = BIDX; t < T / 32; t += GDIM) {
    int row0 = t * 32;
    int b = row0 / L, l0 = row0 % L;
    __syncthreads();
    for (int i = tid; i < 256 * 32; i += NTHREADS) {
      int c = i >> 5, ll = i & 31;
      sm[c * 33 + ll] = P->ohyT[((size_t)b * 256 + c) * L + l0 + ll];
    }
    __syncthreads();
#pragma unroll
    for (int rk = 0; rk < 4; ++rk) {
      const int rr = wid + 8 * rk;
      int row = row0 + rr;
      bf16_t* ao = P->A1 + (size_t)row * D;
      {
        u32x4 raw = *(const u32x4*)(P->oattn + (size_t)row * 512 + lane * 8);
        f32x4 va = unpack4(u32x2{raw[0], raw[1]}), vb = unpack4(u32x2{raw[2], raw[3]});
        float ssm = va[0] * va[0] + va[1] * va[1] + va[2] * va[2] + va[3] * va[3] + vb[0] * vb[0] + vb[1] * vb[1] + vb[2] * vb[2] + vb[3] * vb[3];
        ssm = wave_sum(ssm);
        const float rsm = rsqrtf(ssm * (1.f / 512.f) + EPS);
        u32x4 o = {pack2(va[0] * rsm * ga[0], va[1] * rsm * ga[1]), pack2(va[2] * rsm * ga[2], va[3] * rsm * ga[3]),
                   pack2(vb[0] * rsm * gb[0], vb[1] * rsm * gb[1]), pack2(vb[2] * rsm * gb[2], vb[3] * rsm * gb[3])};
        *(u32x4*)(ao + lane * 8) = o;
      }
      float hv[4];
      float ss = 0.f;
#pragma unroll
      for (int i = 0; i < 4; ++i) { hv[i] = sm[(lane + 64 * i) * 33 + rr]; ss += hv[i] * hv[i]; }
      ss = wave_sum(ss);
      float rs = rsqrtf(ss * (1.f / 256.f) + EPS);
#pragma unroll
      for (int i = 0; i < 4; ++i) ao[512 + lane + 64 * i] = f2bf(hv[i] * rs * ghv[i]);
      {
        const int c = lane * 4;
        f32x4 yfv = *(const f32x4*)(P->yf + (size_t)row * 256 + c), ybv = *(const f32x4*)(P->yb + (size_t)row * 256 + c);
        f32x4 xv = *(const f32x4*)(P->xbc + (size_t)row * 768 + c);
        f32x4 zv = unpack4(*(const u32x2*)(P->zbuf + (size_t)row * 256 + c));
        f32x4 y = yfv + ybv + xv * dh;
        y[0] *= siluf(zv[0]); y[1] *= siluf(zv[1]); y[2] *= siluf(zv[2]); y[3] *= siluf(zv[3]);
        float sg = y[0] * y[0] + y[1] * y[1] + y[2] * y[2] + y[3] * y[3];
        sg += __shfl_xor(sg, 1); sg += __shfl_xor(sg, 2); sg += __shfl_xor(sg, 4); sg += __shfl_xor(sg, 8); sg += __shfl_xor(sg, 16);
        const float rg = rsqrtf(sg * (1.f / 128.f) + EPS);
        const f32x4 g4 = gsv;
        u32x2 o = {pack2(y[0] * rg * g4[0], y[1] * rg * g4[1]), pack2(y[2] * rg * g4[2], y[3] * rg * g4[3])};
        *(u32x2*)(ao + 768 + c) = o;
      }
    }
  }
}

__device__ __forceinline__ void phase_prep5(KP P, int ly, float* sm) {
  LAUNDER_IDS
  const int lane = TIDX & 63;
  const int gw = BIDX * 8 + (TIDX >> 6), nw = GDIM * 8;
  const float* g = P->norm_ffn + ly * D;
  const float* R = P->router + (size_t)ly * D * NE;
  __syncthreads();
  for (int i = TIDX; i < D * NE; i += NTHREADS) { int c = i >> 4, e = i & 15; sm[e * D + c] = R[i]; }
  __syncthreads();
  f32x4 nxv[4], gv[4];
  f32x4 nxp;
  {
    const int r0 = (gw < T) ? gw : 0;
#pragma unroll
    for (int i = 0; i < 4; ++i) { nxv[i] = *(const f32x4*)(P->xcur + (size_t)r0 * D + i * 256 + lane * 4); gv[i] = *(const f32x4*)(g + i * 256 + lane * 4); }
    nxp = *(const f32x4*)(P->p + ((size_t)ly * T + r0) * 256 + lane * 4);
  }
  for (int row = gw; row < T; row += nw) {
    f32x4 v[4];
    f32x4 p4 = nxp;
    float ss = 0.f;
#pragma unroll
    for (int i = 0; i < 4; ++i) {
      v[i] = nxv[i];
      ss += v[i][0] * v[i][0] + v[i][1] * v[i][1] + v[i][2] * v[i][2] + v[i][3] * v[i][3];
    }
    {
      const int nr = (row + nw < T) ? (row + nw) : row;
#pragma unroll
      for (int i = 0; i < 4; ++i) nxv[i] = *(const f32x4*)(P->xcur + (size_t)nr * D + i * 256 + lane * 4);
      nxp = *(const f32x4*)(P->p + ((size_t)ly * T + nr) * 256 + lane * 4);
    }
    ss = wave_sum(ss);
    float rs = rsqrtf(ss * (1.f / D) + EPS);
    bf16_t* ao = P->A1 + (size_t)row * D;
#pragma unroll
    for (int i = 0; i < 4; ++i) {
      int c = i * 256 + lane * 4;
      const f32x4 g4 = gv[i];
      v[i] = v[i] * g4 * rs;
      u32x2 o = {pack2(v[i][0], v[i][1]), pack2(v[i][2], v[i][3])};
      *(u32x2*)(ao + c) = o;
    }
    float lg[16];
    int smoff = lane * 4;
    asm volatile("" : "+v"(smoff));
    const float* smr = sm + smoff;
#pragma unroll
    for (int e = 0; e < 16; ++e) {
      float a = 0.f;
#pragma unroll
      for (int i = 0; i < 4; ++i) {
        f32x4 r4 = *(const f32x4*)(smr + e * D + i * 256);
        a += v[i][0] * r4[0] + v[i][1] * r4[1] + v[i][2] * r4[2] + v[i][3] * r4[3];
      }
      lg[e] = a;
    }
    float r8[8], r4[4], r2[2], r1;
    {
      const bool up = (lane & 32) != 0;
#pragma unroll
      for (int k = 0; k < 8; ++k) { float snd = up ? lg[k] : lg[8 + k]; float keep = up ? lg[8 + k] : lg[k]; r8[k] = keep + __shfl_xor(snd, 32); }
    }
    {
      const bool up = (lane & 16) != 0;
#pragma unroll
      for (int k = 0; k < 4; ++k) { float snd = up ? r8[k] : r8[4 + k]; float keep = up ? r8[4 + k] : r8[k]; r4[k] = keep + __shfl_xor(snd, 16); }
    }
    {
      const bool up = (lane & 8) != 0;
#pragma unroll
      for (int k = 0; k < 2; ++k) { float snd = up ? r4[k] : r4[2 + k]; float keep = up ? r4[2 + k] : r4[k]; r2[k] = keep + __shfl_xor(snd, 8); }
    }
    {
      const bool up = (lane & 4) != 0;
      float snd = up ? r2[0] : r2[1]; float keep = up ? r2[1] : r2[0];
      r1 = keep + __shfl_xor(snd, 4);
    }
    r1 += __shfl_xor(r1, 2);
    r1 += __shfl_xor(r1, 1);
    float mx = r1;
    mx = fmaxf(mx, __shfl_xor(mx, 4)); mx = fmaxf(mx, __shfl_xor(mx, 8)); mx = fmaxf(mx, __shfl_xor(mx, 16)); mx = fmaxf(mx, __shfl_xor(mx, 32));
    const float ex = expf(r1 - mx);
    float se = ex;
    se += __shfl_xor(se, 4); se += __shfl_xor(se, 8); se += __shfl_xor(se, 16); se += __shfl_xor(se, 32);
    const float mine = ex / se;
    int b = row / L, l = row % L;
    if ((lane & 3) == 0) P->affT[((size_t)b * NE + ((lane >> 2) & 15)) * L + l] = mine;
    u32x2 o = {pack2(p4[0], p4[1]), pack2(p4[2], p4[3])};
    *(u32x2*)(P->Ap + (size_t)row * 256 + lane * 4) = o;
  }
}

__device__ __forceinline__ void phase_topk(KP P, char* smem) {
  LAUNDER_IDS
  uint32_t* keys = (uint32_t*)smem;
  int* hist = (int*)(smem + 32768);
  int* misc = hist + 256;
  const int tid = TIDX, lane = tid & 63, wid = tid >> 6;
  for (int it = BIDX; it < NB * NE; it += GDIM) {
    const float* av = P->affT + (size_t)it * L;
    __syncthreads();
    for (int i = tid; i < L; i += NTHREADS) keys[i] = __float_as_uint(av[i]);
    uint32_t prefix = 0, mask = 0;
    int kth = CAP;
    for (int pass = 3; pass >= 0; --pass) {
      int shift = pass * 8;
      if (tid < 256) hist[tid] = 0;
      __syncthreads();
      if (pass == 3) {
        for (int i = tid; i < L; i += NTHREADS) {
          const int bin = (int)(keys[i] >> 24);
          unsigned long long todo = __ballot(1);
          while (todo) {
            const int leader = __builtin_ctzll(todo);
            const int v = __shfl(bin, leader);
            const unsigned long long same = __ballot(bin == v);
            if (lane == leader) atomicAdd(&hist[v], (int)__popcll(same));
            todo &= ~same;
          }
        }
      } else {
        for (int i = tid; i < L; i += NTHREADS) {
          uint32_t k = keys[i];
          if ((k & mask) == prefix) atomicAdd(&hist[(k >> shift) & 255], 1);
        }
      }
      __syncthreads();
      if (wid == 0) {
        int h0 = hist[4 * lane], h1 = hist[4 * lane + 1], h2 = hist[4 * lane + 2], h3 = hist[4 * lane + 3];
        int tot4 = h0 + h1 + h2 + h3;
        int suf = tot4;
#pragma unroll
        for (int o = 1; o < 64; o <<= 1) {
          int v = __shfl_down(suf, o);
          if (lane + o < 64) suf += v;
        }
        int above = suf - tot4;
        int c3 = above, c2 = c3 + h3, c1 = c2 + h2, c0 = c1 + h1;
        int selbin = -1, selrem = 0;
        if (c3 < kth && c3 + h3 >= kth) { selbin = 4 * lane + 3; selrem = kth - c3; }
        else if (c2 < kth && c2 + h2 >= kth) { selbin = 4 * lane + 2; selrem = kth - c2; }
        else if (c1 < kth && c1 + h1 >= kth) { selbin = 4 * lane + 1; selrem = kth - c1; }
        else if (c0 < kth && c0 + h0 >= kth) { selbin = 4 * lane; selrem = kth - c0; }
        if (selbin >= 0) { misc[0] = selbin; misc[1] = selrem; }
      }
      __syncthreads();
      prefix |= ((uint32_t)misc[0]) << shift;
      mask |= 0xFFu << shift;
      kth = misc[1];
      __syncthreads();
    }
    const uint32_t Tk = prefix;
    int cg_ = 0, ce_ = 0;
#pragma unroll
    for (int j = 0; j < 16; ++j) {
      uint32_t k = keys[tid * 16 + j];
      cg_ += (k > Tk);
      ce_ += (k == Tk);
    }
    int packed = cg_ | (ce_ << 16);
    int incl = packed;
#pragma unroll
    for (int o = 1; o < 64; o <<= 1) {
      int nbv = __shfl_up(incl, o);
      if (lane >= o) incl += nbv;
    }
    if (lane == 63) misc[8 + wid] = incl;
    __syncthreads();
    int woff = 0, tot = 0;
    for (int w = 0; w < 8; ++w) {
      int v = misc[8 + w];
      if (w < wid) woff += v;
      tot += v;
    }
    int excl = woff + incl - packed;
    int pg = excl & 0xFFFF, pe = excl >> 16;
    int total_gt = tot & 0xFFFF;
    int* oi = P->idx + it * CAP;
    float* og = P->gsel + it * CAP;
    int* ts = P->tokslot + (size_t)it * L;
#pragma unroll
    for (int j = 0; j < 16; ++j) {
      int i = tid * 16 + j;
      uint32_t k = keys[i];
      int slot = -1;
      if (k > Tk) {
        slot = pg; ++pg;
      } else if (k == Tk) {
        if (pe < kth) slot = total_gt + pe;
        ++pe;
      }
      if (slot >= 0) { oi[slot] = i; og[slot] = __uint_as_float(k); }
      ts[i] = slot;
    }
  }
}

__device__ __forceinline__ void phase_moe_combine_rms(KP P, const float* g) {
  LAUNDER_IDS
  const int lane = TIDX & 63;
  const int gw = BIDX * 8 + (TIDX >> 6), nw = GDIM * 8;
#define CMB_SLOT(r_) ((lane < NE) ? P->tokslot[((size_t)((r_) / L) * NE + lane) * L + ((r_) % L)] : -1)
#define CMB_FIRST(slotv_, b_, q0_, q1_, cnt_, rest_) do { \
    unsigned long long _sel = __ballot((slotv_) >= 0) & 0xffffull; cnt_ = 0; \
    if (_sel) { const int _e0 = __builtin_ctzll(_sel); _sel &= _sel - 1; const int _s0 = __shfl((slotv_), _e0); \
      const bf16_t* _y0 = P->Ybuf + (((size_t)(b_) * NE + _e0) * CAP + _s0) * D; \
      _Pragma("unroll") for (int i = 0; i < 4; ++i) q0_[i] = *(const u32x2*)(_y0 + i * 256 + lane * 4); cnt_ = 1; \
      if (_sel) { const int _e1 = __builtin_ctzll(_sel); _sel &= _sel - 1; const int _s1 = __shfl((slotv_), _e1); \
        const bf16_t* _y1 = P->Ybuf + (((size_t)(b_) * NE + _e1) * CAP + _s1) * D; \
        _Pragma("unroll") for (int i = 0; i < 4; ++i) q1_[i] = *(const u32x2*)(_y1 + i * 256 + lane * 4); cnt_ = 2; } } \
    rest_ = _sel; } while (0)
  f32x4 nxv[4], gv[4];
#pragma unroll
  for (int i = 0; i < 4; ++i) gv[i] = *(const f32x4*)(g + i * 256 + lane * 4);
  u32x2 pa0[4], pa1[4];
  int slotA, slotB, pcnt;
  unsigned long long prest;
  {
    const int r0 = (gw < T) ? gw : 0;
    const int r1 = (r0 + nw < T) ? (r0 + nw) : r0;
#pragma unroll
    for (int i = 0; i < 4; ++i) { nxv[i] = *(const f32x4*)(P->xcur + (size_t)r0 * D + i * 256 + lane * 4); pa0[i] = u32x2{0u, 0u}; pa1[i] = u32x2{0u, 0u}; }
    slotA = CMB_SLOT(r0);
    slotB = CMB_SLOT(r1);
    CMB_FIRST(slotA, r0 / L, pa0, pa1, pcnt, prest);
  }
  for (int row = gw; row < T; row += nw) {
    const int b = row / L;
    float* xr = P->xcur + (size_t)row * D;
    f32x4 v[4];
#pragma unroll
    for (int i = 0; i < 4; ++i) v[i] = nxv[i];
    const int myslot = slotA;
    const int nr = (row + nw < T) ? (row + nw) : row;
    const int nr2 = (nr + nw < T) ? (nr + nw) : nr;
#pragma unroll
    for (int i = 0; i < 4; ++i) nxv[i] = *(const f32x4*)(P->xcur + (size_t)nr * D + i * 256 + lane * 4);
    const int slotC = CMB_SLOT(nr2);
    u32x2 na0[4], na1[4];
    int ncnt; unsigned long long nrest;
#pragma unroll
    for (int i = 0; i < 4; ++i) { na0[i] = u32x2{0u, 0u}; na1[i] = u32x2{0u, 0u}; }
    CMB_FIRST(slotB, nr / L, na0, na1, ncnt, nrest);
    if (pcnt >= 1) {
#pragma unroll
      for (int i = 0; i < 4; ++i) v[i] += unpack4(pa0[i]);
    }
    if (pcnt == 2) {
#pragma unroll
      for (int i = 0; i < 4; ++i) v[i] += unpack4(pa1[i]);
    }
    unsigned long long sel = prest;
    while (sel) {
      const int e0 = __builtin_ctzll(sel); sel &= sel - 1;
      const bool two = sel != 0;
      const int e1 = two ? __builtin_ctzll(sel) : e0;
      if (two) sel &= sel - 1;
      const int sl0 = __shfl(myslot, e0), sl1 = __shfl(myslot, e1);
      const bf16_t* y0 = P->Ybuf + (((size_t)b * NE + e0) * CAP + sl0) * D;
      const bf16_t* y1 = P->Ybuf + (((size_t)b * NE + e1) * CAP + sl1) * D;
      u32x2 a0[4], a1[4];
#pragma unroll
      for (int i = 0; i < 4; ++i) a0[i] = *(const u32x2*)(y0 + i * 256 + lane * 4);
      if (two) {
#pragma unroll
        for (int i = 0; i < 4; ++i) a1[i] = *(const u32x2*)(y1 + i * 256 + lane * 4);
      }
#pragma unroll
      for (int i = 0; i < 4; ++i) v[i] += unpack4(a0[i]);
      if (two) {
#pragma unroll
        for (int i = 0; i < 4; ++i) v[i] += unpack4(a1[i]);
      }
    }
    float ss = 0.f;
#pragma unroll
    for (int i = 0; i < 4; ++i) {
      *(f32x4*)(xr + i * 256 + lane * 4) = v[i];
      ss += v[i][0] * v[i][0] + v[i][1] * v[i][1] + v[i][2] * v[i][2] + v[i][3] * v[i][3];
    }
    ss = wave_sum(ss);
    const float rs = rsqrtf(ss * (1.f / D) + EPS);
    bf16_t* ao = P->A1 + (size_t)row * D;
#pragma unroll
    for (int i = 0; i < 4; ++i) {
      const int c = i * 256 + lane * 4;
      const f32x4 g4 = gv[i];
      u32x2 o = {pack2(v[i][0] * rs * g4[0], v[i][1] * rs * g4[1]), pack2(v[i][2] * rs * g4[2], v[i][3] * rs * g4[3])};
      *(u32x2*)(ao + c) = o;
    }
    slotA = slotB; slotB = slotC; pcnt = ncnt; prest = nrest;
#pragma unroll
    for (int i = 0; i < 4; ++i) { pa0[i] = na0[i]; pa1[i] = na1[i]; }
  }
#undef CMB_SLOT
#undef CMB_FIRST
}

__device__ __forceinline__ void phase_final(KP P) {
  LAUNDER_IDS
  const int lane = TIDX & 63;
  const int gw = BIDX * 8 + (TIDX >> 6), nw = GDIM * 8;
  if (gw >= T) return;
  const float* xsrc = P->xcur;
  f32x4 cur[4], nx[4], gv[4];
#pragma unroll
  for (int i = 0; i < 4; ++i) { cur[i] = *(const f32x4*)(xsrc + (size_t)gw * D + i * 256 + lane * 4); gv[i] = *(const f32x4*)(P->final_norm + i * 256 + lane * 4); }
  for (int row = gw; row < T; row += nw) {
    const int nr = (row + nw < T) ? (row + nw) : row;
#pragma unroll
    for (int i = 0; i < 4; ++i) nx[i] = *(const f32x4*)(xsrc + (size_t)nr * D + i * 256 + lane * 4);
    float ss = 0.f;
#pragma unroll
    for (int i = 0; i < 4; ++i) ss += cur[i][0] * cur[i][0] + cur[i][1] * cur[i][1] + cur[i][2] * cur[i][2] + cur[i][3] * cur[i][3];
    ss = wave_sum(ss);
    const float rs = rsqrtf(ss * (1.f / D) + EPS);
#pragma unroll
    for (int i = 0; i < 4; ++i) {
      const int c = i * 256 + lane * 4;
      const f32x4 g4 = gv[i];
      *(f32x4*)(P->out + (size_t)row * D + c) = cur[i] * g4 * rs;
    }
#pragma unroll
    for (int i = 0; i < 4; ++i) cur[i] = nx[i];
  }
}

__global__ void __launch_bounds__(NTHREADS, 2) mega(Params Pval) {
  extern __shared__ __attribute__((aligned(16))) char smem[];
  cg::grid_group grid = cg::this_grid();
  float* smf = (float*)smem;
  KP P = (KP)__builtin_amdgcn_kernarg_segment_ptr();
  volatile XLAS unsigned* xst = (volatile XLAS unsigned*)(smem + SMEM_USER);
  if (threadIdx.x == 0) { xst[0] = 0u; xst[1] = 0u; xst[2] = 0u; xst[3] = 0u; }
  if (blockIdx.x == 0) {
    for (int i = threadIdx.x; i < XCD_BAR_WORDS; i += NTHREADS) P->bar[i] = 0u;
    __threadfence();
  }
  __syncthreads();
#define XBAR() do { LND(); XcdBarrier _xb; _xb.bar = P->bar; _xb.x = xb_xcc_id(); _xb.st = (volatile XLAS unsigned*)(smem + SMEM_USER); xcd_barrier(_xb); } while (0)
#define LND() asm volatile("" : "+s"(P) : : "memory")
#define LAYER(ly) do { \
    LND(); phase_convert(P, ly, smf); \
    LND(); phase_rms_x(P, (ly == 0) ? P->x : P->xcur, P->norm_mix + ly * D, P->A1); \
    if (ly == 0) { grid.sync(); (void)xcd_barrier_post(P->bar, xst); } else XBAR(); \
    LND(); phase_g8_inproj(P, ly, smem); \
    LND(); phase_filters(P, ly, smf, 64); \
    LND(); phase_convert_down(P, ly, smem); \
    XBAR(); \
    LND(); phase_gemm_qkv(P, smem); \
    LND(); phase_ssd1(P, ly, smem); \
    LND(); phase_hyena_fft(P, ly, (float2*)smem); \
    XBAR(); \
    LND(); phase_ssd_scan(P); \
    XBAR(); \
    LND(); phase_attn_mfma(P, smem); \
    LND(); phase_ssd3(P, ly, smem); \
    XBAR(); \
    LND(); phase_prep4(P, ly, smf); \
    XBAR(); \
    LND(); phase_g8_out(P, ly, smem); \
    XBAR(); \
    LND(); phase_prep5(P, ly, smf); \
    XBAR(); \
    LND(); phase_topk(P, smem); \
    LND(); phase_g8_pp(P, smem); \
    LND(); phase_convert_gu(P, ly, smem); \
    XBAR(); \
    LND(); phase_g8_moe1(P, smem); \
    XBAR(); \
    LND(); phase_g8_moe2(P, smem); \
    XBAR(); \
    LND(); phase_moe_combine_rms(P, P->ple_norm + ly * D); \
    XBAR(); \
    LND(); phase_g8_ple(P, smem); \
    XBAR(); \
  } while (0)
  LAYER(0);
  LAYER(1);
  LND(); phase_final(P);
}

extern "C" void kernel_launch(void* const* d_in, const int* in_sizes, int n_in, void* d_out, int out_size, void* d_ws,
                              size_t ws_size, hipStream_t stream) {
  static int grid_blocks = 0;
  if (!grid_blocks) {
    int dev = 0, cus = 0, per_cu = 0;
    (void)hipGetDevice(&dev);
    (void)hipDeviceGetAttribute(&cus, hipDeviceAttributeMultiprocessorCount, dev);
    (void)hipFuncSetAttribute((const void*)mega, hipFuncAttributeMaxDynamicSharedMemorySize, SMEM_BYTES);
    (void)hipOccupancyMaxActiveBlocksPerMultiprocessor(&per_cu, mega, NTHREADS, SMEM_BYTES);
    if (per_cu < 1) per_cu = 1;
    if (per_cu > 1) per_cu = 1;
    grid_blocks = cus * per_cu;
  }
  Params P;
  memset(&P, 0, sizeof(P));
  const float* const* in = (const float* const*)d_in;
  P.x = in[0]; P.p = in[1]; P.pos = (const int*)d_in[2];
  P.norm_mix = in[3]; P.w_in = in[4]; P.q_norm = in[5]; P.w_uq = in[6]; P.kv_norm = in[7]; P.w_ukv = in[8];
  P.mla_out_norm = in[9]; P.hy_conv_w = in[10]; P.hy_conv_b = in[11]; P.hy_w1 = in[12]; P.hy_b1 = in[13]; P.hy_freq = in[14];
  P.hy_w2 = in[15]; P.hy_b2 = in[16]; P.hy_w3 = in[17]; P.hy_decay = in[18]; P.hy_bias = in[19]; P.hy_out_norm = in[20];
  P.ssm_conv_w = in[21]; P.ssm_conv_b = in[22]; P.ssm_dt_bias = in[23]; P.ssm_a_log = in[24]; P.ssm_d = in[25]; P.ssm_norm = in[26];
  P.w_out = in[27]; P.norm_ffn = in[28]; P.router = in[29]; P.w_gate = in[30]; P.w_up = in[31]; P.w_down = in[32];
  P.ple_norm = in[33]; P.ple_gate_w = in[34]; P.ple_proj = in[35]; P.final_norm = in[36];
  P.out = (float*)d_out;
  char* w = (char*)d_ws;
  size_t off = 0;
  auto take = [&](size_t bytes) { char* r = w + off; off += (bytes + 255) & ~(size_t)255; return r; };
  P.Win_t = (bf16_t*)take((size_t)NINP * D * 2);
  P.Wuq_t = (bf16_t*)take((size_t)768 * 256 * 2);
  P.Wukv_t = (bf16_t*)take((size_t)1024 * 128 * 2);
  P.Wout_t = (bf16_t*)take((size_t)D * D * 2);
  P.Wgu_t = (bf16_t*)take((size_t)NE * 2 * FF * D * 2);
  P.Wd_t = (bf16_t*)take((size_t)NE * D * FF * 2);
  P.Wpg_t = (bf16_t*)take((size_t)D * D * 2);
  P.Wpp_t = (bf16_t*)take((size_t)D * 256 * 2);
  P.xcur = (float*)take((size_t)T * D * 4);
  P.A1 = (bf16_t*)take((size_t)T * D * 2);
  size_t r1 = (size_t)T * NIN * 4;
  char* R1 = take(r1);
  P.proj = (float*)R1;
  P.H = (bf16_t*)R1;
  P.Aq = (bf16_t*)take((size_t)T * 256 * 2);
  P.Akv = (bf16_t*)take((size_t)T * 128 * 2);
  char* R2 = take((size_t)T * 768 * 4 + (size_t)T * 1024 * 4);
  P.qraw = (float*)R2;
  P.kvraw = (float*)(R2 + (size_t)T * 768 * 4);
  P.PP = (float*)R2;
  P.PPb = (bf16_t*)R2;
  P.Ap = (bf16_t*)(R2 + (size_t)T * 1024 * 4);
  P.Qb = (bf16_t*)take((size_t)T * 768 * 2);
  P.Kn = (bf16_t*)take((size_t)T * 512 * 2);
  P.Kr = (bf16_t*)take((size_t)T * 32 * 2);
  P.Vt = (bf16_t*)take((size_t)T * 512 * 2);
  P.oattn = (bf16_t*)take((size_t)T * 512 * 2);
  P.huT = (float*)take((size_t)T * 768 * 4);
  P.filtT = (_Float16*)take((size_t)1024 * L * 2);
  P.v1T = (float*)take((size_t)T * 256 * 4);
  P.ohyT = (float*)take((size_t)T * 256 * 4);
  P.KFb = (h16x2*)take((size_t)256 * 2 * FFT_N * 4);
  P.xbc = (float*)take((size_t)T * 768 * 4);
  P.xbcr = (bf16_t*)take((size_t)T * 768 * 2);
  P.ssq_q = (float*)take((size_t)T * 4 * 4);
  P.ssq_kv = (float*)take((size_t)T * 4 * 4);
  P.dtv = (float*)take((size_t)T * 8 * 4);
  P.zbuf = (bf16_t*)take((size_t)T * 256 * 2);
  P.yf = (float*)take((size_t)T * 256 * 4);
  P.yb = (float*)take((size_t)T * 256 * 4);
  P.states = (float*)take((size_t)1024 * 8192 * 4);
  P.prevb = (bf16_t*)take((size_t)1024 * 8192 * 2);
  P.cdec = (float*)take((size_t)1024 * 4);
  P.bar = (unsigned*)take((size_t)XCD_BAR_WORDS * 4);
  P.affT = (float*)take((size_t)NB * NE * L * 4);
  P.idx = (int*)take((size_t)NB * NE * CAP * 4);
  P.tokslot = (int*)take((size_t)NB * NE * L * 4);
  P.Ybuf = (bf16_t*)P.huT;
  P.gsel = (float*)take((size_t)NB * NE * CAP * 4);
  if (off > ws_size) {
    fprintf(stderr, "kernel_launch: workspace too small: need %zu have %zu\n", off, ws_size);
    return;
  }
  void* args[] = {&P};
  hipError_t e = hipLaunchCooperativeKernel((void*)mega, dim3(grid_blocks), dim3(NTHREADS), args, SMEM_BYTES, stream);
  if (e != hipSuccess) fprintf(stderr, "cooperative launch failed: %s (grid %d)\n", hipGetErrorString(e), grid_blocks);
}
```
